# Optimizing an MI355X kernel written in HIP

```python
import math
import jax, jax.numpy as jnp
from jax import lax
import numpy as np

D_MODEL = 2048
BATCH = 4
SEQ = 2048
DEPTH = 2

HEAD_DIM = 128
DIL_GROUPS = ((128, 1), (512, 4), (2048, 16))
DIL_HEADS_PER_GROUP = 4
DIL_HEADS = DIL_HEADS_PER_GROUP * len(DIL_GROUPS)
FOX_HEADS = 8
N_HEADS = DIL_HEADS + FOX_HEADS
N_BRANCHES = 2
QKV_COLS = 3 * N_HEADS * HEAD_DIM
IN_COLS = QKV_COLS + FOX_HEADS + N_BRANCHES * D_MODEL
A_OUT = DIL_HEADS_PER_GROUP * HEAD_DIM
B_OUT = FOX_HEADS * HEAD_DIM
BLOCK = 128
ROPE_THETA = 10000.0
NEG_INF = -1e30
RMS_EPS = 1e-6
PEER_HEADS = 8
N_KEYS = 128
N_EXPERTS = N_KEYS * N_KEYS
PEER_KEY_HALF = 128
PEER_TOPK = 16
PEER_CHUNK = 128

kernel_name = "hybrid_dilated_fox_peer_block"


def rms_norm(x, gain):
    xf = x.astype(jnp.float32)
    y = xf * lax.rsqrt(jnp.mean(xf * xf, axis=-1, keepdims=True) + RMS_EPS)
    return (y * gain).astype(x.dtype)


def rotary(x, positions):
    half = HEAD_DIM // 2
    inv_freq = ROPE_THETA ** (-jnp.arange(half, dtype=jnp.float32) / half)
    ang = positions.astype(jnp.float32)[:, None] * inv_freq[None, :]
    cos = jnp.cos(ang)[None, :, None, :]
    sin = jnp.sin(ang)[None, :, None, :]
    xf = x.astype(jnp.float32)
    x1, x2 = xf[..., :half], xf[..., half:]
    return jnp.concatenate([x1 * cos - x2 * sin, x2 * cos + x1 * sin], axis=-1).astype(x.dtype)


def dilated_window_attention(q, k, v, dilation, n_back):
    b, s, h, d = q.shape
    s_sub = s // dilation
    n_pad = (-s_sub) % BLOCK
    nb = (s_sub + n_pad) // BLOCK

    def to_sub(t):
        t = t.reshape(b, s_sub, dilation, h, d).transpose(0, 2, 3, 1, 4)
        t = jnp.pad(t, ((0, 0), (0, 0), (0, 0), (0, n_pad), (0, 0)))
        return t.reshape(b, dilation, h, nb, BLOCK, d)

    def with_prev(t):
        prev = jnp.pad(t, ((0, 0), (0, 0), (0, 0), (1, 0), (0, 0), (0, 0)))[:, :, :, :-1]
        return jnp.concatenate([prev, t], axis=4)

    qs = to_sub(q)
    kk = with_prev(to_sub(k))
    vv = with_prev(to_sub(v))
    scores = jnp.einsum('brhnqd,brhnkd->brhnqk', qs, kk).astype(jnp.float32) * (d ** -0.5)
    blk = jnp.arange(nb)[:, None]
    q_pos = blk * BLOCK + jnp.arange(BLOCK)[None, :]
    k_pos = (blk - 1) * BLOCK + jnp.arange(2 * BLOCK)[None, :]
    dist = q_pos[:, :, None] - k_pos[:, None, :]
    valid = (dist >= 0) & (dist <= n_back) & (k_pos[:, None, :] >= 0)
    scores = jnp.where(valid, scores, NEG_INF)
    lse = jax.nn.logsumexp(scores, axis=-1)
    probs = jnp.exp(scores - lse[..., None]).astype(v.dtype)
    out = jnp.einsum('brhnqk,brhnkd->brhnqd', probs, vv)

    def from_sub(t):
        t = t.reshape((b, dilation, h, nb * BLOCK) + t.shape[5:])[:, :, :, :s_sub]
        t = jnp.moveaxis(t, 3, 1)
        return t.reshape((b, s, h) + t.shape[4:])

    return from_sub(out), from_sub(lse)


def forgetting_attention(q, k, v, log_f):
    b, s, h, d = q.shape
    nb = s // BLOCK
    decay = jnp.cumsum(log_f, axis=1)
    k_decay = decay.transpose(0, 2, 1)
    k_pos = jnp.arange(s)
    qb = q.reshape(b, nb, BLOCK, h, d).transpose(1, 0, 2, 3, 4)
    db = decay.reshape(b, nb, BLOCK, h).transpose(1, 0, 3, 2)

    def one_block(args):
        q_blk, dec_blk, n = args
        q_pos = n * BLOCK + jnp.arange(BLOCK)
        scores = jnp.einsum('bqhd,bkhd->bhqk', q_blk, k).astype(jnp.float32) * (d ** -0.5)
        scores = scores + dec_blk[..., None] - k_decay[:, :, None, :]
        scores = jnp.where(k_pos[None, :] <= q_pos[:, None], scores, NEG_INF)
        probs = jax.nn.softmax(scores, axis=-1).astype(v.dtype)
        return jnp.einsum('bhqk,bkhd->bqhd', probs, v)

    out = lax.map(one_block, (qb, db, jnp.arange(nb)))
    return out.transpose(1, 0, 2, 3, 4).reshape(b, s, h, d)


def peer_ffn(xn, w_query, sub_keys, expert_u, expert_v):
    b, s, dm = xn.shape
    t = b * s
    x_tok = xn.reshape(t, dm)
    query = (x_tok @ w_query).reshape(t, PEER_HEADS, 2, PEER_KEY_HALF)
    half_scores = jnp.einsum('thcd,hcnd->thcn', query, sub_keys)
    top_s, top_i = lax.top_k(half_scores, PEER_TOPK)
    cand_s = (top_s[:, :, 0, :, None] + top_s[:, :, 1, None, :]).reshape(t, PEER_HEADS, PEER_TOPK * PEER_TOPK)
    cand_i = (top_i[:, :, 0, :, None] * N_KEYS + top_i[:, :, 1, None, :]).reshape(t, PEER_HEADS, PEER_TOPK * PEER_TOPK)
    best_s, best_pos = lax.top_k(cand_s, PEER_TOPK)
    expert_idx = jnp.take_along_axis(cand_i, best_pos, axis=-1)
    gates = jax.nn.softmax(best_s.astype(jnp.float32), axis=-1).astype(xn.dtype)
    n_chunks = t // PEER_CHUNK

    def one_chunk(args):
        xc, ic, gc = args
        u = expert_u[ic]
        v = expert_v[ic]
        act = jax.nn.gelu(jnp.einsum('cd,chkd->chk', xc, u), approximate=False)
        return jnp.einsum('chk,chkd->cd', gc * act, v)

    out = lax.map(one_chunk, (x_tok.reshape(n_chunks, PEER_CHUNK, dm),
                              expert_idx.reshape(n_chunks, PEER_CHUNK, PEER_HEADS, PEER_TOPK),
                              gates.reshape(n_chunks, PEER_CHUNK, PEER_HEADS, PEER_TOPK)))
    return out.reshape(b, s, dm)


def setup_inputs(seed: int = 0) -> dict:
    key = jax.random.key(seed)
    ks = jax.random.split(key, 15)
    f32 = jnp.float32
    nrm = lambda k, shape: jax.random.normal(k, shape, dtype=f32)
    return {
        'x': nrm(ks[0], (BATCH, SEQ, D_MODEL)),
        'mix_norm': 1.0 + 0.1 * nrm(ks[1], (DEPTH, D_MODEL)),
        'w_in': nrm(ks[2], (DEPTH, D_MODEL, IN_COLS)) * D_MODEL ** -0.5,
        'b_forget': 2.0 + 0.5 * nrm(ks[3], (DEPTH, FOX_HEADS)),
        'b_gate': 0.1 * nrm(ks[4], (DEPTH, N_BRANCHES, D_MODEL)),
        'q_norm': 1.0 + 0.1 * nrm(ks[5], (DEPTH, N_HEADS, HEAD_DIM)),
        'k_norm': 1.0 + 0.1 * nrm(ks[6], (DEPTH, N_HEADS, HEAD_DIM)),
        'w_branch_a': nrm(ks[7], (DEPTH, A_OUT, D_MODEL)) * A_OUT ** -0.5,
        'w_branch_b': nrm(ks[8], (DEPTH, B_OUT, D_MODEL)) * B_OUT ** -0.5,
        'w_out': nrm(ks[9], (DEPTH, D_MODEL, D_MODEL)) * D_MODEL ** -0.5,
        'ffn_norm': 1.0 + 0.1 * nrm(ks[10], (DEPTH, D_MODEL)),
        'w_query': nrm(ks[11], (DEPTH, D_MODEL, PEER_HEADS * 2 * PEER_KEY_HALF)) * D_MODEL ** -0.5,
        'sub_keys': nrm(ks[12], (DEPTH, PEER_HEADS, 2, N_KEYS, PEER_KEY_HALF)) * PEER_KEY_HALF ** -0.5,
        'expert_u': nrm(ks[13], (DEPTH, N_EXPERTS, D_MODEL)) * D_MODEL ** -0.5,
        'expert_v': nrm(ks[14], (DEPTH, N_EXPERTS, D_MODEL)) * PEER_HEADS ** -0.5,
    }


def reference(x, mix_norm, w_in, b_forget, b_gate, q_norm, k_norm, w_branch_a, w_branch_b,
              w_out, ffn_norm, w_query, sub_keys, expert_u, expert_v):
    b, s, _ = x.shape
    positions = jnp.arange(s)
    for l in range(DEPTH):
        xn = rms_norm(x, mix_norm[l])
        proj = xn @ w_in[l]
        qkv = proj[..., :QKV_COLS].reshape(b, s, 3, N_HEADS, HEAD_DIM)
        f_logit = proj[..., QKV_COLS:QKV_COLS + FOX_HEADS] + b_forget[l]
        gate = jax.nn.sigmoid(proj[..., QKV_COLS + FOX_HEADS:].reshape(b, s, N_BRANCHES, D_MODEL) + b_gate[l])
        q = rms_norm(qkv[:, :, 0], q_norm[l])
        k = rms_norm(qkv[:, :, 1], k_norm[l])
        v = qkv[:, :, 2]

        qa = rotary(q[:, :, :DIL_HEADS], positions)
        ka = rotary(k[:, :, :DIL_HEADS], positions)
        outs, lses = [], []
        for gi, (window, dilation) in enumerate(DIL_GROUPS):
            sl = slice(gi * DIL_HEADS_PER_GROUP, (gi + 1) * DIL_HEADS_PER_GROUP)
            o_g, lse_g = dilated_window_attention(qa[:, :, sl], ka[:, :, sl], v[:, :, sl],
                                                  dilation, window // dilation)
            outs.append(o_g)
            lses.append(lse_g)
        weights = jax.nn.softmax(jnp.stack(lses, axis=0), axis=0)
        o_a = jnp.sum(weights[..., None].astype(v.dtype) * jnp.stack(outs, axis=0), axis=0)
        o_a = o_a.reshape(b, s, A_OUT)

        log_f = jax.nn.log_sigmoid(f_logit.astype(jnp.float32))
        o_b = forgetting_attention(q[:, :, DIL_HEADS:], k[:, :, DIL_HEADS:], v[:, :, DIL_HEADS:], log_f)
        o_b = o_b.reshape(b, s, B_OUT)

        merged = gate[:, :, 0] * (o_a @ w_branch_a[l]) + gate[:, :, 1] * (o_b @ w_branch_b[l])
        x = x + merged @ w_out[l]

        x = x + peer_ffn(rms_norm(x, ffn_norm[l]), w_query[l], sub_keys[l], expert_u[l], expert_v[l])
    return x
```

```cpp
#include <hip/hip_runtime.h>
#include <cstdio>
#include <cstdint>

constexpr int DM = 2048, NBATCH = 4, SEQ = 2048, DEPTH = 2, HD = 128;
constexpr int T = NBATCH * SEQ;
constexpr int DIL_HEADS = 12, FOX_HEADS = 8, NHEADS = 20;
constexpr int QKV_COLS = 3 * NHEADS * HD;
constexpr int IN_COLS = QKV_COLS + FOX_HEADS + 2 * DM;
constexpr int GATE_COL0 = QKV_COLS + FOX_HEADS;
constexpr int NPACK = QKV_COLS + 2 * DM;
constexpr int A_OUT = 512, B_OUT = 1024;
constexpr int PEER_HEADS = 8, NKEYS = 128, NEXP = NKEYS * NKEYS, TOPK = 16;
constexpr float RMS_EPS = 1e-6f;
constexpr float LOG2E = 1.4426950408889634f;
constexpr float QSCALE = 0.08838834764831845f * LOG2E;

constexpr size_t MiB = 1u << 20;
constexpr size_t WS_CTL = 0, CTL_ZERO_BYTES = 1 * MiB;
constexpr size_t WS_WF = 512 * 1024;
constexpr size_t WS_WIN = 1 * MiB;
constexpr size_t WS_WBA = 93 * MiB;
constexpr size_t WS_WBB = 97 * MiB;
constexpr size_t WS_WOUT = 105 * MiB;
constexpr size_t WS_WQ = 121 * MiB;
constexpr size_t WS_SK = 137 * MiB;
constexpr size_t WS_EU = 138 * MiB;
constexpr size_t WS_EV = 266 * MiB;
constexpr size_t WS_EUS = 202 * MiB;
constexpr size_t WS_EVS = 330 * MiB;
constexpr size_t WS_XN = 394 * MiB;
constexpr size_t WS_PROJ = 426 * MiB;
constexpr size_t WS_GATE = 546 * MiB;
constexpr size_t WS_Q = 610 * MiB, WS_K = 650 * MiB, WS_V = 690 * MiB;
constexpr size_t WS_OA = 730 * MiB;
constexpr size_t WS_OB = 738 * MiB;
constexpr size_t WS_MERGED = 754 * MiB;
constexpr size_t WS_X1 = 786 * MiB;
constexpr size_t WS_QUERY = 850 * MiB;
constexpr size_t WS_XCUR = 882 * MiB;
constexpr size_t WS_LOGF = 946 * MiB;
constexpr size_t WS_PARTSS = WS_LOGF + 512 * 1024;
constexpr size_t WS_KBIAS = 947 * MiB;
constexpr size_t WS_ZBIAS = WS_KBIAS + 512 * 1024;
constexpr size_t WS_XN8 = 948 * MiB;
constexpr size_t WS_ROT = 964 * MiB;
constexpr size_t WS_END = 965 * MiB;
constexpr int MRG_SHIFT = 4, X1_SHIFT = 3, O_SHIFT = 5, GATE_SHIFT = 4;
constexpr int WIN_SHIFT = 6;
constexpr int CW_BAR = 4096;

constexpr int NWAVES = 8, NTHREADS = NWAVES * 64;
constexpr int LDS_BYTES = 147456;
constexpr int MISC_OFF = 131072;

#define LAS __attribute__((address_space(3)))
typedef unsigned short bf16_t;
typedef unsigned v4u __attribute__((ext_vector_type(4)));
typedef unsigned v2u __attribute__((ext_vector_type(2)));
typedef float f32x4 __attribute__((ext_vector_type(4)));
typedef __bf16 bf16x2_t __attribute__((ext_vector_type(2)));
#define LDS_WAIT() asm volatile("s_waitcnt lgkmcnt(0)" ::: "memory")

__device__ __forceinline__ float bf2f(unsigned b) { return __uint_as_float(b << 16); }
__device__ __forceinline__ float bflo(unsigned w) { return __uint_as_float(w << 16); }
__device__ __forceinline__ float bfhi(unsigned w) { return __uint_as_float(w & 0xffff0000u); }
__device__ __forceinline__ unsigned f2bf(float f) { unsigned u = __float_as_uint(f); return (u + 0x7fffu + ((u >> 16) & 1u)) >> 16; }
__device__ __forceinline__ unsigned pk2(float lo, float hi) { return f2bf(lo) | (f2bf(hi) << 16); }
__device__ __forceinline__ float dot2(unsigned a, unsigned b, float acc) {
    return __builtin_amdgcn_fdot2_f32_bf16(__builtin_bit_cast(bf16x2_t, a), __builtin_bit_cast(bf16x2_t, b), acc, false);
}
__device__ __forceinline__ float wave_sum(float v) {
#pragma unroll
    for (int o = 1; o < 64; o <<= 1) v += __shfl_xor(v, o);
    return v;
}
__device__ __forceinline__ unsigned wave_max_u(unsigned v) {
#pragma unroll
    for (int o = 1; o < 64; o <<= 1) { unsigned t = (unsigned)__shfl_xor((int)v, o); v = t > v ? t : v; }
    return v;
}
__device__ __forceinline__ unsigned ord_f(float f) { unsigned u = __float_as_uint(f); return (u & 0x80000000u) ? ~u : (u | 0x80000000u); }
__device__ __forceinline__ float unord_f(unsigned u) { return __uint_as_float((u & 0x80000000u) ? (u & 0x7fffffffu) : ~u); }

#define XB_TMO      128
#define XB_XCNT(j)  (256  + 64 * (j))
#define XB_XSUB(j)  (1280 + 64 * (j))
#define XB_XGEN(j)  (2304 + 64 * (j))
#define XB_TOP      3328
#define XB_TOPGEN   3392
#define XCD_BAR_WORDS 3456
#define XB_SPIN_CAP (1u << 22)

__device__ __forceinline__ unsigned xb_ld(unsigned* p)              { return __hip_atomic_load(p, __ATOMIC_RELAXED, __HIP_MEMORY_SCOPE_AGENT); }
__device__ __forceinline__ unsigned xb_add(unsigned* p, unsigned v) { return __hip_atomic_fetch_add(p, v, __ATOMIC_RELAXED, __HIP_MEMORY_SCOPE_AGENT); }
__device__ __forceinline__ unsigned xb_xcc_id() { return (unsigned)__builtin_amdgcn_s_getreg((3 << 11) | 20) & 0xFu; }
#define XB_SPIN(cond, bar) do { unsigned _sp = 0; while (cond) { __builtin_amdgcn_s_sleep(1); \
    if ((++_sp & 255u) == 0u) { if (xb_ld(&(bar)[XB_TMO])) break; if (_sp > XB_SPIN_CAP) { atomicAdd(&(bar)[XB_TMO], 1u); break; } } } } while (0)

struct XcdBarrier { unsigned* bar; unsigned x; volatile LAS unsigned* st; };

__device__ __forceinline__ XcdBarrier xcd_barrier_post(unsigned* bar, volatile LAS unsigned* st, const int tid) {
    XcdBarrier b; b.bar = bar; b.x = xb_xcc_id(); b.st = st;
    if (tid == 0) (void)xb_add(&bar[XB_XCNT(b.x)], 1u);
    return b;
}
__device__ __forceinline__ void xcd_barrier_complete(unsigned* bar, unsigned x, unsigned& nloc, unsigned& nx) {
    const unsigned G = gridDim.x * gridDim.y * gridDim.z;
    unsigned sum, cnt, mine, sp = 0u;
    for (;;) {
        sum = 0u; cnt = 0u; mine = 0u;
#pragma unroll
        for (unsigned j = 0; j < 16; ++j) { const unsigned c = xb_ld(&bar[XB_XCNT(j)]); sum += c; cnt += (c > 0u) ? 1u : 0u; mine = (j == x) ? c : mine; }
        if (sum == G) break;
        __builtin_amdgcn_s_sleep(1);
        if ((++sp & 255u) == 0u) { if (xb_ld(&bar[XB_TMO])) break; if (sp > XB_SPIN_CAP) { atomicAdd(&bar[XB_TMO], 1u); break; } }
    }
    nloc = mine > 0u ? mine : 1u; nx = cnt > 0u ? cnt : 1u;
}
__device__ __forceinline__ void xcd_barrier(const XcdBarrier& b, const int tid) {
    asm volatile("s_waitcnt vmcnt(0)" ::: "memory");
    __syncthreads();
    if (tid == 0) {
        unsigned* bar = b.bar;
        __builtin_amdgcn_s_waitcnt(0);
        unsigned nloc = b.st[0], nx = b.st[1];
        if (nloc == 0u) { xcd_barrier_complete(bar, b.x, nloc, nx); b.st[0] = nloc; b.st[1] = nx; }
        const unsigned old = xb_add(&bar[XB_XSUB(b.x)], 1u);
        const unsigned gen = old / nloc;
        if (old + 1u == (gen + 1u) * nloc) {
            __builtin_amdgcn_fence(__ATOMIC_RELEASE, "agent");
            asm volatile("s_waitcnt vmcnt(0)" ::: "memory");
            const unsigned og = xb_add(&bar[XB_TOP], 1u);
            const unsigned tg = og / nx;
            if (og + 1u == (tg + 1u) * nx) xb_add(&bar[XB_TOPGEN], 1u);
            else XB_SPIN(xb_ld(&bar[XB_TOPGEN]) == tg, bar);
            __builtin_amdgcn_fence(__ATOMIC_ACQUIRE, "agent");
            xb_add(&bar[XB_XGEN(b.x)], 1u);
            asm volatile("s_waitcnt vmcnt(0)" ::: "memory");
        } else {
            XB_SPIN(xb_ld(&bar[XB_XGEN(b.x)]) == gen, bar);
            __builtin_amdgcn_fence(__ATOMIC_ACQUIRE, "agent");
            asm volatile("s_waitcnt vmcnt(0)" ::: "memory");
        }
    }
    __syncthreads();
}

struct Args {
    const float* in[15];
    float* out;
    unsigned char* ws;
};
enum { I_X = 0, I_MIXN, I_WIN, I_BF, I_BG, I_QN, I_KN, I_WBA, I_WBB, I_WOUT, I_FFNN, I_WQ, I_SK, I_EU, I_EV };

struct Ctx { int tid, lane, wave, gw, ngw; LAS unsigned char* lds; char* ldsg; };

typedef short p0_bf16x8 __attribute__((ext_vector_type(8)));
typedef float p0_f32x16 __attribute__((ext_vector_type(16)));
__device__ __forceinline__ void transpose_item(const float* W, int ld, int col0, int K, int N, bf16_t* WT, int row_off, LAS float* scr, int item, int lane, const float* kgain = nullptr) {
    const int nblk = N / 32, kb = item / nblk, nb = item % nblk, k0 = 64 * kb, n0 = 32 * nb;
#pragma unroll
    for (int i = 0; i < 32; ++i) { const int kk = 2 * i + (lane >> 5); scr[kk * 33 + (lane & 31)] = W[(size_t)(k0 + kk) * ld + col0 + n0 + (lane & 31)] * (kgain ? kgain[k0 + kk] : 1.0f); }
    LDS_WAIT();
    const int c = lane & 7;
#pragma unroll
    for (int j = 0; j < 4; ++j) { const int n = (lane >> 3) + 8 * j; const LAS float* s = scr + (8 * c) * 33 + n;
        v4u o; o.x = pk2(s[0 * 33], s[1 * 33]); o.y = pk2(s[2 * 33], s[3 * 33]); o.z = pk2(s[4 * 33], s[5 * 33]); o.w = pk2(s[6 * 33], s[7 * 33]);
        *(v4u*)(WT + (size_t)(row_off + n0 + n) * K + k0 + 8 * c) = o; }
    LDS_WAIT();
}
__device__ __forceinline__ int qk_perm_col(int col) {
    if (col >= 2 * NHEADS * HD) return col;
    const int d = col & 127, hb = col & ~127;
    return hb + (d < 64 ? 8 * (d >> 2) + (d & 3) : 8 * ((d - 64) >> 2) + 4 + (d & 3));
}
template <bool QKPERM>
__device__ __forceinline__ void transpose_item_fp8(const float* W, int ld, int col0, int K, int N, unsigned char* WT, int row_off, LAS float* scr, int item, int lane, const float* kgain = nullptr) {
    const int nblk = N / 32, kb = item / nblk, nb = item % nblk, k0 = 64 * kb, n0 = 32 * nb;
#pragma unroll
    for (int i = 0; i < 32; ++i) { const int kk = 2 * i + (lane >> 5); scr[kk * 33 + (lane & 31)] = W[(size_t)(k0 + kk) * ld + col0 + n0 + (lane & 31)] * (kgain ? kgain[k0 + kk] : 1.0f); }
    LDS_WAIT();
    constexpr float SC = (float)(1 << WIN_SHIFT);
#pragma unroll
    for (int j = 0; j < 2; ++j) { const int id = lane + 64 * j, n = id >> 2, c = id & 3; const LAS float* sp = scr + (16 * c) * 33 + n;
        v4u o;
#pragma unroll
        for (int i = 0; i < 4; ++i) { int w = __builtin_amdgcn_cvt_pk_fp8_f32(sp[(4 * i) * 33] * SC, sp[(4 * i + 1) * 33] * SC, 0, false); w = __builtin_amdgcn_cvt_pk_fp8_f32(sp[(4 * i + 2) * 33] * SC, sp[(4 * i + 3) * 33] * SC, w, true);
            if (i == 0) o.x = (unsigned)w; else if (i == 1) o.y = (unsigned)w; else if (i == 2) o.z = (unsigned)w; else o.w = (unsigned)w; }
        const int drow = QKPERM ? qk_perm_col(n0 + n) : n0 + n;
        *(v4u*)(WT + (size_t)(row_off + drow) * K + k0 + 16 * c) = o; }
    LDS_WAIT();
}
__device__ __forceinline__ void convert_flat(const float* src, bf16_t* dst, size_t n, const Ctx& c) {
    const size_t n8 = n / 8, stride = (size_t)gridDim.x * NTHREADS;
    for (size_t i = (size_t)blockIdx.x * NTHREADS + c.tid; i < n8; i += stride) {
        const f32x4 a = *(const f32x4*)(src + i * 8), b = *(const f32x4*)(src + i * 8 + 4);
        v4u o; o.x = pk2(a.x, a.y); o.y = pk2(a.z, a.w); o.z = pk2(b.x, b.y); o.w = pk2(b.z, b.w);
        *(v4u*)(dst + i * 8) = o;
    }
}
__device__ __forceinline__ void convert_fp8_rows(const float* src, unsigned char* dst, float* scales, int nrows, const Ctx& c, const float* cgain = nullptr) {
    for (int row = c.gw; row < nrows; row += c.ngw) {
        const float* sp = src + (size_t)row * DM + 16 * c.lane;
        const float* gp = cgain ? cgain + (size_t)(row / NEXP) * DM + 16 * c.lane : nullptr;
        f32x4 v[8]; float am = 0.f;
#pragma unroll
        for (int hf = 0; hf < 2; ++hf)
#pragma unroll
            for (int i = 0; i < 4; ++i) { f32x4 x = *(const f32x4*)(sp + hf * 1024 + 4 * i); if (gp) x *= *(const f32x4*)(gp + hf * 1024 + 4 * i); v[hf * 4 + i] = x;
                am = fmaxf(am, fmaxf(fmaxf(fabsf(x.x), fabsf(x.y)), fmaxf(fabsf(x.z), fabsf(x.w)))); }
#pragma unroll
        for (int o = 1; o < 64; o <<= 1) am = fmaxf(am, __shfl_xor(am, o));
        const float inv = am > 0.f ? 240.0f / am : 0.f;
#pragma unroll
        for (int hf = 0; hf < 2; ++hf) { v4u o;
#pragma unroll
            for (int i = 0; i < 4; ++i) { const f32x4 x = v[hf * 4 + i];
                int w = __builtin_amdgcn_cvt_pk_fp8_f32(x.x * inv, x.y * inv, 0, false); w = __builtin_amdgcn_cvt_pk_fp8_f32(x.z * inv, x.w * inv, w, true);
                if (i == 0) o.x = (unsigned)w; else if (i == 1) o.y = (unsigned)w; else if (i == 2) o.z = (unsigned)w; else o.w = (unsigned)w; }
            *(v4u*)(dst + (size_t)row * DM + hf * 1024 + 16 * c.lane) = o; }
        if (c.lane == 0) scales[row] = am > 0.f ? am * (1.0f / 240.0f) : 1.0f;
    }
}
constexpr int F6_ROW = 1536;
typedef unsigned v6u __attribute__((ext_vector_type(6)));
typedef _Float16 v32h_t __attribute__((ext_vector_type(32)));
__device__ __forceinline__ void convert_fp6_rows(const float* src, unsigned char* dst, float* scales, int nrows, const Ctx& c, const float* cgain = nullptr) {
    f32x4 nx[8];
    if (c.gw < nrows) {
#pragma unroll
        for (int i = 0; i < 8; ++i) nx[i] = *(const f32x4*)(src + (size_t)c.gw * DM + 16 * c.lane + (i >> 2) * 1024 + 4 * (i & 3));
    }
#pragma unroll 1
    for (int row = c.gw; row < nrows; row += c.ngw) {
        const float* gp = cgain ? cgain + (size_t)(row / NEXP) * DM + 16 * c.lane : nullptr;
        f32x4 v[8]; float am = 0.f;
#pragma unroll
        for (int i = 0; i < 8; ++i) v[i] = nx[i];
        { const int rn = row + c.ngw < nrows ? row + c.ngw : row;
#pragma unroll
          for (int i = 0; i < 8; ++i) nx[i] = *(const f32x4*)(src + (size_t)rn * DM + 16 * c.lane + (i >> 2) * 1024 + 4 * (i & 3)); }
#pragma unroll
        for (int i = 0; i < 8; ++i) { f32x4 x = v[i]; if (gp) x *= *(const f32x4*)(gp + (i >> 2) * 1024 + 4 * (i & 3)); v[i] = x;
            am = fmaxf(am, fmaxf(fmaxf(fabsf(x.x), fabsf(x.y)), fmaxf(fabsf(x.z), fabsf(x.w)))); }
#pragma unroll
        for (int o = 1; o < 64; o <<= 1) am = fmaxf(am, __shfl_xor(am, o));
        const float inv = am > 0.f ? 7.5f / am : 0.f;
        v32h_t h;
#pragma unroll
        for (int j = 0; j < 8; ++j) { h[4 * j] = (_Float16)(v[j].x * inv); h[4 * j + 1] = (_Float16)(v[j].y * inv); h[4 * j + 2] = (_Float16)(v[j].z * inv); h[4 * j + 3] = (_Float16)(v[j].w * inv); }
        const v6u p = __builtin_amdgcn_cvt_scalef32_pk32_fp6_f16(h, 1.0f);
        unsigned char* rp = dst + (size_t)row * F6_ROW;
        *(v4u*)(rp + 16 * c.lane) = (v4u){p[0], p[1], p[2], p[3]}; *(v2u*)(rp + 1024 + 8 * c.lane) = (v2u){p[4], p[5]};
        if (c.lane == 0) scales[2 * (size_t)row] = am > 0.f ? am * (1.0f / 7.5f) : 1.0f;
    }
}
__device__ __forceinline__ void transpose_item64(const float* W, int ld, int col0, int K, int N, unsigned char* WT, int row_off, bool perm, int item, int lane) {
    const int nblk = N / 64, kb = item / nblk, nb = item - kb * nblk, k0 = 64 * kb, n = 64 * nb + lane;
    const float* wp = W + (size_t)k0 * ld + col0 + 64 * nb;
    float x[64];
#pragma unroll
    for (int kk = 0; kk < 64; ++kk) x[kk] = *(const float*)((const char*)(wp + (size_t)kk * ld) + (unsigned)(lane * 4));
    constexpr float SC = (float)(1 << WIN_SHIFT);
    unsigned char* op = WT + (size_t)(row_off + (perm ? qk_perm_col(n) : n)) * K + k0;
#pragma unroll
    for (int j = 0; j < 4; ++j) { v4u o;
#pragma unroll
        for (int i = 0; i < 4; ++i) { const int b = 16 * j + 4 * i; int w = __builtin_amdgcn_cvt_pk_fp8_f32(x[b] * SC, x[b + 1] * SC, 0, false); w = __builtin_amdgcn_cvt_pk_fp8_f32(x[b + 2] * SC, x[b + 3] * SC, w, true);
            if (i == 0) o.x = (unsigned)w; else if (i == 1) o.y = (unsigned)w; else if (i == 2) o.z = (unsigned)w; else o.w = (unsigned)w; }
        *(v4u*)(op + 16 * j) = o; }
}
constexpr int T64_IN0 = (DM / 64) * (QKV_COLS / 64), T64_IN1 = (DM / 64) * (2 * DM / 64), T64_BA = (A_OUT / 64) * (DM / 64), T64_BB = (B_OUT / 64) * (DM / 64), T64_OUT = (DM / 64) * (DM / 64),
              T64_LAYER = T64_IN0 + T64_IN1 + T64_BA + T64_BB + T64_OUT;
__device__ __forceinline__ void transpose_layer_item64(const float* win, const float* wba, const float* wbb, const float* wout, unsigned char* win8, unsigned char* wba8, unsigned char* wbb8, unsigned char* wout8, int r, int lane) {
    const float* W; int ld, col0, K, N, row_off = 0; unsigned char* WT; bool perm = false;
    if (r < T64_IN0) { W = win; ld = IN_COLS; col0 = 0; K = DM; N = QKV_COLS; WT = win8; perm = true; }
    else if ((r -= T64_IN0) < T64_IN1) { W = win; ld = IN_COLS; col0 = GATE_COL0; K = DM; N = 2 * DM; WT = win8; row_off = QKV_COLS; }
    else if ((r -= T64_IN1) < T64_BA) { W = wba; ld = DM; col0 = 0; K = A_OUT; N = DM; WT = wba8; }
    else if ((r -= T64_BA) < T64_BB) { W = wbb; ld = DM; col0 = 0; K = B_OUT; N = DM; WT = wbb8; }
    else { r -= T64_BB; W = wout; ld = DM; col0 = 0; K = DM; N = DM; WT = wout8; }
    transpose_item64(W, ld, col0, K, N, WT, row_off, perm, r, lane);
}
__device__ __forceinline__ void convert_fp6_rows_b4(const float* src, unsigned char* dst, float* scales, int row0, int rstride, int rowend, int lane, const float* cgain = nullptr) {
#pragma unroll 1
    for (int rb = row0; rb < rowend; rb += 4 * rstride) {
        f32x4 v[4][8];
#pragma unroll
        for (int q = 0; q < 4; ++q) { const int rq = rb + q * rstride < rowend ? rb + q * rstride : rb;
#pragma unroll
            for (int i = 0; i < 8; ++i) v[q][i] = *(const f32x4*)(src + (size_t)rq * DM + 16 * lane + (i >> 2) * 1024 + 4 * (i & 3)); }
#pragma unroll
        for (int q = 0; q < 4; ++q) { const int row = rb + q * rstride;
            const float* gp = cgain ? cgain + (size_t)(rb / NEXP) * DM + 16 * lane : nullptr; float am = 0.f;
#pragma unroll
            for (int i = 0; i < 8; ++i) { f32x4 x = v[q][i]; if (gp) x *= *(const f32x4*)(gp + (i >> 2) * 1024 + 4 * (i & 3)); v[q][i] = x;
                am = fmaxf(am, fmaxf(fmaxf(fabsf(x.x), fabsf(x.y)), fmaxf(fabsf(x.z), fabsf(x.w)))); }
#pragma unroll
            for (int o = 1; o < 64; o <<= 1) am = fmaxf(am, __shfl_xor(am, o));
            const float inv = am > 0.f ? 7.5f / am : 0.f;
            v32h_t h;
#pragma unroll
            for (int j = 0; j < 8; ++j) { h[4 * j] = (_Float16)(v[q][j].x * inv); h[4 * j + 1] = (_Float16)(v[q][j].y * inv); h[4 * j + 2] = (_Float16)(v[q][j].z * inv); h[4 * j + 3] = (_Float16)(v[q][j].w * inv); }
            const v6u p = __builtin_amdgcn_cvt_scalef32_pk32_fp6_f16(h, 1.0f);
            if (row < rowend) { unsigned char* rp = dst + (size_t)row * F6_ROW;
                *(v4u*)(rp + 16 * lane) = (v4u){p[0], p[1], p[2], p[3]}; *(v2u*)(rp + 1024 + 8 * lane) = (v2u){p[4], p[5]};
                if (lane == 0) scales[2 * (size_t)row] = am > 0.f ? am * (1.0f / 7.5f) : 1.0f; }
        }
    }
}
constexpr int EV_SPLIT = 16384;
__device__ __forceinline__ void phase_convert(const __attribute__((address_space(4))) Args* ka, const Ctx& c0) {
    Ctx c = c0; c.gw = blockIdx.x * NWAVES + c0.wave; c.ngw = gridDim.x * NWAVES;
    constexpr int NTH = NTHREADS;
    LAS float* scr = (LAS float*)(c.lds + c.wave * 16384);
    constexpr int I_IN0 = (DM / 64) * (QKV_COLS / 32), I_IN1 = (DM / 64) * (2 * DM / 32), I_BA = (A_OUT / 64) * (DM / 32), I_BB = (B_OUT / 64) * (DM / 32),
                  I_OUT = (DM / 64) * (DM / 32), I_LAYER = I_IN0 + I_IN1 + I_BA + I_BB + I_OUT;
    unsigned char* win8 = (unsigned char*)(ka->ws + WS_WIN); bf16_t* wba_t = (bf16_t*)(ka->ws + WS_WBA); bf16_t* wbb_t = (bf16_t*)(ka->ws + WS_WBB);
    bf16_t* wout_t = (bf16_t*)(ka->ws + WS_WOUT); bf16_t* wq_t = (bf16_t*)(ka->ws + WS_WQ);
    for (int it = c.gw; it < (DEPTH - 1) * 0 + I_LAYER; it += c.ngw) {
        const int l = it / I_LAYER; int r = it - l * I_LAYER;
        const float* win = ka->in[I_WIN] + (size_t)l * DM * IN_COLS;
        if (r < I_IN0) { transpose_item_fp8<true>(win, IN_COLS, 0, DM, QKV_COLS, win8 + (size_t)l * NPACK * DM, 0, scr, r, c.lane); continue; } r -= I_IN0;
        if (r < I_IN1) { transpose_item_fp8<false>(win, IN_COLS, GATE_COL0, DM, 2 * DM, win8 + (size_t)l * NPACK * DM, QKV_COLS, scr, r, c.lane); continue; } r -= I_IN1;
        if (r < I_BA) { transpose_item_fp8<false>(ka->in[I_WBA] + (size_t)l * A_OUT * DM, DM, 0, A_OUT, DM, (unsigned char*)wba_t + (size_t)l * DM * A_OUT, 0, scr, r, c.lane); continue; } r -= I_BA;
        if (r < I_BB) { transpose_item_fp8<false>(ka->in[I_WBB] + (size_t)l * B_OUT * DM, DM, 0, B_OUT, DM, (unsigned char*)wbb_t + (size_t)l * DM * B_OUT, 0, scr, r, c.lane); continue; } r -= I_BB;
        { transpose_item_fp8<false>(ka->in[I_WOUT] + (size_t)l * DM * DM, DM, 0, DM, DM, (unsigned char*)wout_t + (size_t)l * DM * DM, 0, scr, r, c.lane); continue; }
    }
    { float* rot = (float*)(ka->ws + WS_ROT);
      for (int i = blockIdx.x * NTH + c.tid; i < SEQ * 64; i += gridDim.x * NTH) { const int pos = i >> 6, fi = i & 63;
          float sn, cs; sincosf((float)pos * exp2f(-(float)fi * (13.287712379549449f / 64.0f)), &sn, &cs); rot[i] = cs; rot[SEQ * 64 + i] = sn; } }
    { float* wfg = (float*)(ka->ws + WS_WF);
      for (int i = blockIdx.x * NTH + c.tid; i < DEPTH * DM; i += gridDim.x * NTH) { const int l = i / DM, k = i % DM; const float* wp = ka->in[I_WIN] + ((size_t)l * DM + k) * IN_COLS + QKV_COLS;
          const f32x4 w0 = *(const f32x4*)wp, w1 = *(const f32x4*)(wp + 4); float* d = wfg + (size_t)l * 8 * DM + k;
          d[0] = w0.x; d[DM] = w0.y; d[2 * DM] = w0.z; d[3 * DM] = w0.w; d[4 * DM] = w1.x; d[5 * DM] = w1.y; d[6 * DM] = w1.z; d[7 * DM] = w1.w; } }
    { bf16_t* wqk = (bf16_t*)(ka->ws + WS_WQ); const int r32 = c.lane & 31, hi = c.lane >> 5;
      for (int it = c.gw; it < DEPTH * 16 * 64 * 4; it += c.ngw) {
          const int l = it >> 12, rr = it & 4095, hh = rr >> 8, kt = (rr >> 2) & 63, jt = rr & 3;
          const float* skp = ka->in[I_SK] + ((size_t)(l * 16 + hh) * NKEYS + jt * 32 + r32) * HD + 8 * hi;
          const float* wqp = ka->in[I_WQ] + (size_t)l * DM * DM + (size_t)(kt * 32 + r32) * DM + hh * HD + 8 * hi;
          const float g = ka->in[I_FFNN][(size_t)l * DM + kt * 32 + r32];
          p0_f32x16 acc = {};
#pragma unroll
          for (int sidx = 0; sidx < 8; ++sidx) {
              const f32x4 a0 = *(const f32x4*)(skp + 16 * sidx), a1 = *(const f32x4*)(skp + 16 * sidx + 4), b0 = *(const f32x4*)(wqp + 16 * sidx) * g, b1 = *(const f32x4*)(wqp + 16 * sidx + 4) * g;
              const p0_bf16x8 av = __builtin_bit_cast(p0_bf16x8, (v4u){pk2(a0.x, a0.y), pk2(a0.z, a0.w), pk2(a1.x, a1.y), pk2(a1.z, a1.w)});
              const p0_bf16x8 bv = __builtin_bit_cast(p0_bf16x8, (v4u){pk2(b0.x, b0.y), pk2(b0.z, b0.w), pk2(b1.x, b1.y), pk2(b1.z, b1.w)});
              acc = __builtin_amdgcn_mfma_f32_32x32x16_bf16(av, bv, acc, 0, 0, 0); }
          unsigned char* op = (unsigned char*)wqk + (size_t)l * DM * DM + (size_t)(hh * HD + hi * 64 + jt * 16) * DM + kt * 32 + r32;
#pragma unroll
          for (int r = 0; r < 16; ++r) op[(size_t)r * DM] = (unsigned char)(__builtin_amdgcn_cvt_pk_fp8_f32(acc[r] * (float)(1 << WIN_SHIFT), 0.f, 0, false) & 0xff); } }
}

__device__ __forceinline__ float log_sigmoid(float z) { return fminf(z, 0.f) - log1pf(expf(-fabsf(z))); }
template <bool LOGF>
__device__ __forceinline__ void rmsnorm_row(const float* xin, const float* gain, bf16_t* out, const float* win_l, const float* bf_l, float* logf, const Ctx& c, const int row) {
    {
        const f32x4* xr = (const f32x4*)(xin + (size_t)row * DM) + c.lane;
        f32x4 v[8]; float ss = 0.f;
#pragma unroll
        for (int j = 0; j < 8; ++j) { v[j] = xr[64 * j]; ss += (v[j].x * v[j].x + v[j].y * v[j].y) + (v[j].z * v[j].z + v[j].w * v[j].w); }
        ss = wave_sum(ss);
        const float rstd = 1.0f / sqrtf(ss * (1.0f / DM) + RMS_EPS);
#pragma unroll
        for (int j = 0; j < 8; ++j) {
            const f32x4 g = ((const f32x4*)gain)[c.lane + 64 * j];
            if (LOGF) {
                int w = __builtin_amdgcn_cvt_pk_fp8_f32(v[j].x * rstd * g.x, v[j].y * rstd * g.y, 0, false); w = __builtin_amdgcn_cvt_pk_fp8_f32(v[j].z * rstd * g.z, v[j].w * rstd * g.w, w, true);
                ((unsigned*)((unsigned char*)out + (size_t)row * DM))[c.lane + 64 * j] = (unsigned)w;
            } else { v2u o; o.x = pk2(v[j].x * rstd * g.x, v[j].y * rstd * g.y); o.y = pk2(v[j].z * rstd * g.z, v[j].w * rstd * g.w); ((v2u*)(out + (size_t)row * DM))[c.lane + 64 * j] = o; }
        }
        float f[8] = {0.f, 0.f, 0.f, 0.f, 0.f, 0.f, 0.f, 0.f};
        if (LOGF) {
#pragma unroll 1
            for (int j = 0; j < 8; ++j) {
                const f32x4 xv = xr[64 * j], g = ((const f32x4*)gain)[c.lane + 64 * j];
                const float y[4] = {xv.x * rstd * g.x, xv.y * rstd * g.y, xv.z * rstd * g.z, xv.w * rstd * g.w};
#pragma unroll
                for (int e = 0; e < 4; ++e) {
                    const int k = 4 * c.lane + 256 * j + e;
                    const f32x4 w0 = *(const f32x4*)(win_l + (size_t)k * IN_COLS + QKV_COLS), w1 = *(const f32x4*)(win_l + (size_t)k * IN_COLS + QKV_COLS + 4);
                    f[0] += y[e] * w0.x; f[1] += y[e] * w0.y; f[2] += y[e] * w0.z; f[3] += y[e] * w0.w; f[4] += y[e] * w1.x; f[5] += y[e] * w1.y; f[6] += y[e] * w1.z; f[7] += y[e] * w1.w;
                }
            }
        }
        if (LOGF) {
#pragma unroll
            for (int h = 0; h < 8; ++h) { const float s = wave_sum(f[h]); if (c.lane == h) logf[(size_t)row * 8 + h] = log_sigmoid(s + bf_l[h]); }
        }
    }
}

template <bool XB16> __device__ __forceinline__ f32x4 ld_x4(const float* base, size_t elem) {
    if (XB16) { const v2u w = *(const v2u*)((const bf16_t*)base + elem); return (f32x4){bflo(w.x), bfhi(w.x), bflo(w.y), bfhi(w.y)}; }
    return *(const f32x4*)(base + elem);
}
template <class WP, bool XB16 = false>
__device__ __forceinline__ void rmsnorm_rows4(const float* xin, const float* gain, bf16_t* out, WP wf, const float* bf_l, float* logf, const int lane, const int row0) {
    float rstd[4];
#pragma unroll
    for (int q = 0; q < 4; ++q) {
        f32x4 v[8]; float ss = 0.f;
#pragma unroll
        for (int j = 0; j < 8; ++j) { v[j] = ld_x4<XB16>(xin, (size_t)(row0 + q) * DM + 4 * (lane + 64 * j)); ss += (v[j].x * v[j].x + v[j].y * v[j].y) + (v[j].z * v[j].z + v[j].w * v[j].w); }
        ss = wave_sum(ss);
        const float rs = __builtin_amdgcn_rsqf(ss * (1.0f / DM) + RMS_EPS); rstd[q] = rs;
#pragma unroll
        for (int j = 0; j < 8; ++j) { const f32x4 g = ((const f32x4*)gain)[lane + 64 * j];
            int w = __builtin_amdgcn_cvt_pk_fp8_f32(v[j].x * rs * g.x, v[j].y * rs * g.y, 0, false); w = __builtin_amdgcn_cvt_pk_fp8_f32(v[j].z * rs * g.z, v[j].w * rs * g.w, w, true);
            ((unsigned*)((unsigned char*)out + (size_t)(row0 + q) * DM))[lane + 64 * j] = (unsigned)w; }
        asm volatile("" ::: "memory");
    }
    float f[32];
#pragma unroll
    for (int i = 0; i < 32; ++i) f[i] = 0.f;
#pragma unroll 1
    for (int j = 0; j < 8; ++j) {
        const f32x4 g = ((const f32x4*)gain)[lane + 64 * j];
        f32x4 y[4];
#pragma unroll
        for (int q = 0; q < 4; ++q) { const f32x4 xv = ld_x4<XB16>(xin, (size_t)(row0 + q) * DM + 4 * (lane + 64 * j)); y[q] = xv * rstd[q] * g; }
#pragma unroll
        for (int h = 0; h < 8; ++h) { const f32x4 w = *(const f32x4*)(wf + h * DM + 4 * lane + 256 * j);
#pragma unroll
            for (int q = 0; q < 4; ++q) f[q * 8 + h] += (y[q].x * w.x + y[q].y * w.y) + (y[q].z * w.z + y[q].w * w.w); }
    }
#pragma unroll
    for (int i = 0; i < 16; ++i) { const float keep = (lane & 32) ? f[i + 16] : f[i], send = (lane & 32) ? f[i] : f[i + 16]; f[i] = keep + __shfl_xor(send, 32); }
#pragma unroll
    for (int i = 0; i < 8; ++i) { const float keep = (lane & 16) ? f[i + 8] : f[i], send = (lane & 16) ? f[i] : f[i + 8]; f[i] = keep + __shfl_xor(send, 16); }
#pragma unroll
    for (int i = 0; i < 4; ++i) { const float keep = (lane & 8) ? f[i + 4] : f[i], send = (lane & 8) ? f[i] : f[i + 4]; f[i] = keep + __shfl_xor(send, 8); }
#pragma unroll
    for (int i = 0; i < 2; ++i) { const float keep = (lane & 4) ? f[i + 2] : f[i], send = (lane & 4) ? f[i] : f[i + 2]; f[i] = keep + __shfl_xor(send, 4); }
    { const float keep = (lane & 2) ? f[1] : f[0], send = (lane & 2) ? f[0] : f[1]; f[0] = keep + __shfl_xor(send, 2); }
    f[0] += __shfl_xor(f[0], 1);
    if ((lane & 1) == 0) { const int idx = lane >> 1, q = idx >> 3, h = idx & 7; logf[(size_t)(row0 + q) * 8 + h] = log_sigmoid(f[0] + bf_l[h]); }
}
__device__ __forceinline__ void phase_rmsnorm4(const float* xin, const float* gain, bf16_t* out, const float* win_l, const float* bf_l, float* logf, const Ctx& c) {
    LAS float* wfl = (LAS float*)c.lds;
    __syncthreads();
#pragma unroll 1
    for (int i = 0; i < DM / NTHREADS; ++i) { const int k = c.tid + NTHREADS * i;
        const f32x4 w0 = *(const f32x4*)(win_l + (size_t)k * IN_COLS + QKV_COLS), w1 = *(const f32x4*)(win_l + (size_t)k * IN_COLS + QKV_COLS + 4);
        wfl[0 * DM + k] = w0.x; wfl[1 * DM + k] = w0.y; wfl[2 * DM + k] = w0.z; wfl[3 * DM + k] = w0.w; wfl[4 * DM + k] = w1.x; wfl[5 * DM + k] = w1.y; wfl[6 * DM + k] = w1.z; wfl[7 * DM + k] = w1.w; }
    __syncthreads();
    for (int g = c.gw; g < T / 4; g += c.ngw) rmsnorm_rows4<const LAS float*>(xin, gain, out, (const LAS float*)wfl, bf_l, logf, c.lane, 4 * g);
    __syncthreads();
}
template <bool LOGF>
__device__ __forceinline__ void phase_rmsnorm(const float* xin, const float* gain, bf16_t* out, const float* win_l, const float* bf_l, float* logf, const Ctx& c) {
    for (int row = c.gw; row < T; row += c.ngw) rmsnorm_row<LOGF>(xin, gain, out, win_l, bf_l, logf, c, row);
}

template <class Epi>
__device__ __forceinline__ void gemm_naive(const bf16_t* A, const bf16_t* Bt, int M, int N, int K, const Epi& epi, const Ctx& c) {
    const int tm = c.tid >> 5, tn = c.tid & 31, ntn = N / 32, ntiles = (M / 16) * ntn;
    for (int tile = blockIdx.x; tile < ntiles; tile += gridDim.x) {
        const int row = (tile / ntn) * 16 + tm, col = (tile % ntn) * 32 + tn;
        const v4u* ap = (const v4u*)(A + (size_t)row * K); const v4u* bp = (const v4u*)(Bt + (size_t)col * K);
        float a0 = 0.f, a1 = 0.f, a2 = 0.f, a3 = 0.f;
#pragma unroll 4
        for (int k = 0; k < K / 8; ++k) { const v4u va = ap[k], vb = bp[k]; a0 = dot2(va.x, vb.x, a0); a1 = dot2(va.y, vb.y, a1); a2 = dot2(va.z, vb.z, a2); a3 = dot2(va.w, vb.w, a3); }
        epi(row, col, (a0 + a1) + (a2 + a3));
    }
}
struct EpiProj { bf16_t* proj; bf16_t* gate;
    __device__ __forceinline__ void operator()(int row, int col, float v) const {
        if (col < QKV_COLS) proj[(size_t)row * QKV_COLS + col] = (bf16_t)f2bf(v); else gate[(size_t)row * (2 * DM) + (col - QKV_COLS)] = (bf16_t)f2bf(v); } };
struct EpiResidual { const float* xin; float* xout;
    __device__ __forceinline__ void operator()(int row, int col, float v) const { xout[(size_t)row * DM + col] = xin[(size_t)row * DM + col] + v; } };
struct EpiBf16Out { bf16_t* o; int ld;
    __device__ __forceinline__ void operator()(int row, int col, float v) const { o[(size_t)row * ld + col] = (bf16_t)f2bf(v); } };
__device__ __forceinline__ float sigmoidf(float z) { return 1.0f / (1.0f + expf(-z)); }
__device__ __forceinline__ void phase_branch_naive(const bf16_t* oa, const bf16_t* ob, const bf16_t* wba_t, const bf16_t* wbb_t, const bf16_t* gate, const float* bg_l, bf16_t* merged, const Ctx& c) {
    const int tm = c.tid >> 5, tn = c.tid & 31, ntn = DM / 32, ntiles = (T / 16) * ntn;
    for (int tile = blockIdx.x; tile < ntiles; tile += gridDim.x) {
        const int row = (tile / ntn) * 16 + tm, col = (tile % ntn) * 32 + tn;
        float accA, accB;
        { const v4u* ap = (const v4u*)(oa + (size_t)row * A_OUT); const v4u* bp = (const v4u*)(wba_t + (size_t)col * A_OUT);
          float a0 = 0.f, a1 = 0.f, a2 = 0.f, a3 = 0.f;
#pragma unroll 4
          for (int k = 0; k < A_OUT / 8; ++k) { const v4u va = ap[k], vb = bp[k]; a0 = dot2(va.x, vb.x, a0); a1 = dot2(va.y, vb.y, a1); a2 = dot2(va.z, vb.z, a2); a3 = dot2(va.w, vb.w, a3); }
          accA = (a0 + a1) + (a2 + a3); }
        { const v4u* ap = (const v4u*)(ob + (size_t)row * B_OUT); const v4u* bp = (const v4u*)(wbb_t + (size_t)col * B_OUT);
          float a0 = 0.f, a1 = 0.f, a2 = 0.f, a3 = 0.f;
#pragma unroll 4
          for (int k = 0; k < B_OUT / 8; ++k) { const v4u va = ap[k], vb = bp[k]; a0 = dot2(va.x, vb.x, a0); a1 = dot2(va.y, vb.y, a1); a2 = dot2(va.z, vb.z, a2); a3 = dot2(va.w, vb.w, a3); }
          accB = (a0 + a1) + (a2 + a3); }
        const float gA = sigmoidf(bf2f(gate[(size_t)row * (2 * DM) + col]) + bg_l[col]);
        const float gB = sigmoidf(bf2f(gate[(size_t)row * (2 * DM) + DM + col]) + bg_l[DM + col]);
        merged[(size_t)row * DM + col] = (bf16_t)f2bf(gA * accA + gB * accB);
    }
}


namespace pg8 {
#define PG8_LAS __attribute__((address_space(3)))
typedef unsigned short bf16_t;
typedef short bf16x8 __attribute__((ext_vector_type(8)));
typedef float f32x4 __attribute__((ext_vector_type(4)));
typedef unsigned u32x4 __attribute__((ext_vector_type(4)));
typedef int pg8_v4i __attribute__((ext_vector_type(4)));
typedef int pg8_v8i __attribute__((ext_vector_type(8)));
constexpr int BM = 256, BK = 64, HALF = 128, HTB = HALF * BK * 2  , STAGE_BYTES = 8 * HTB, NXCD = 8, WGM = 8;

__host__ __device__ __forceinline__ int lds_byte(int r, int c) { const int st = (r >> 4) * 2 + (c >> 5), rr = r & 15, cc = c & 31, ob = rr * 64 + cc * 2; return st * 1024 + (ob ^ (((ob >> 9) & 1) << 5)); }
__host__ __device__ __forceinline__ void stage_rc(int b, int& R, int& C) { const int st = b / 1024, sb = b % 1024, swz = sb ^ (((sb >> 9) & 1) << 5); R = (st >> 1) * 16 + swz / 64; C = (st & 1) * 32 + (swz % 64) / 2; }
__host__ __device__ __forceinline__ int perm32(int rho) { const int n = rho >> 4, i = rho & 15; return 8 * (i >> 2) + 4 * n + (i & 3); }

struct Unit { int pm, pn; };
struct Gemm { const bf16_t* A; const bf16_t* Bt; int M, N, K; };

struct StaticOrder {
    int nM, nN, nwg, G, c;
    __host__ __device__ void init(int M, int N, int G_, int c_) { nM = M / BM; nN = N / BM; nwg = nM * nN; G = G_; c = c_; }
    __host__ __device__ __forceinline__ bool next(int i, Unit& u) const {
        const long L = (long)i * G + c; if (L >= nwg) return false;
        int wgid = (int)L; { const int q = nwg / NXCD, r = nwg % NXCD, xcd = wgid % NXCD, off = wgid / NXCD; wgid = (xcd < r ? xcd * (q + 1) : r * (q + 1) + (xcd - r) * q) + off; }
        const int nig = WGM * nN, gid = wgid / nig, fm = gid * WGM, gsz = (nM - fm) < WGM ? (nM - fm) : WGM;
        u.pm = fm + ((wgid % nig) % gsz); u.pn = (wgid % nig) / gsz; return true;
    }
    __device__ __forceinline__ void a_ready(const Unit&) const {}
    __device__ __forceinline__ void done(const Unit&) const {}
};
__device__ __forceinline__ unsigned cvt_pk_bf16(float lo, float hi) { unsigned r; asm volatile("v_cvt_pk_bf16_f32 %0, %1, %2" : "=v"(r) : "v"(lo), "v"(hi)); return r; }
template <class Epi, class Sched, bool ALIGN_EPI = false, bool SP2 = false, bool FP8 = false, bool ZERO = true, int XSHIFT = 0>
__device__ __forceinline__ void gemm_phase_acc(PG8_LAS unsigned char* lds, const Gemm g, const Sched& S, const Epi& E, const int tid, f32x4 (&acc)[2][2][4][2]) {
    const int  wid = __builtin_amdgcn_readfirstlane(tid >> 6), lane = tid & 63, wr = wid >> 2, wc = wid & 3, fr = lane & 15, fq = lane >> 4;
    const int K = g.K, nt = K / BK;
    unsigned voffA[2], voffB[2];
#pragma unroll
    for (int i = 0; i < 2; ++i) { int R, C; stage_rc(tid * 16 + i * 8192, R, C); const int Rb = Epi::PERM ? ((R & ~31) + perm32(R & 31)) : R;
        voffA[i] = (unsigned)(R * K + C) * 2u; voffB[i] = (unsigned)(Rb * K + C) * 2u; }
    const size_t kstep = (size_t)(BK * 2);
    const size_t hstep = (size_t)HALF * K * 2;
    const size_t tstep = 2 * hstep;
    const unsigned ldsw = (unsigned)wid * 1024u;
    const int aoff = lds_byte(wr * 64 + fr, fq * 8), boff = lds_byte(wc * 32 + fr, fq * 8);
#define PG8_SA(b, h) (((b) * 2 + (h)) * HTB)
#define PG8_SB(b, h) ((4 + (b) * 2 + (h)) * HTB)
#define PG8_STAGE(bufoff, gbase, voff) do { _Pragma("unroll") for (int _i = 0; _i < 2; ++_i) \
        __builtin_amdgcn_global_load_lds((const unsigned*)((const char*)(gbase) + (voff)[_i]), (PG8_LAS unsigned*)(lds + (bufoff) + ldsw + _i * 8192), 16, 0, 0); } while (0)
#define PG8_LD8(p_) __builtin_shufflevector(*(const PG8_LAS pg8_v4i*)(p_), *(const PG8_LAS pg8_v4i*)((p_) + 1024), 0, 1, 2, 3, 4, 5, 6, 7)
#define PG8_LDA(dst, b, h) do { if constexpr (FP8) { _Pragma("unroll") for (int m = 0; m < 4; ++m) dst##8[m] = PG8_LD8(lds + PG8_SA(b, h) + aoff + m * 2048); } \
        else { _Pragma("unroll") for (int m = 0; m < 4; ++m) _Pragma("unroll") for (int k = 0; k < 2; ++k) dst[m][k] = *(const PG8_LAS bf16x8*)(lds + PG8_SA(b, h) + aoff + m * 2048 + k * 1024); } } while (0)
#define PG8_LDB(dst, b, h) do { if constexpr (FP8) { _Pragma("unroll") for (int n = 0; n < 2; ++n) dst##8[n] = PG8_LD8(lds + PG8_SB(b, h) + boff + n * 2048); } \
        else { _Pragma("unroll") for (int n = 0; n < 2; ++n) _Pragma("unroll") for (int k = 0; k < 2; ++k) dst[n][k] = *(const PG8_LAS bf16x8*)(lds + PG8_SB(b, h) + boff + n * 2048 + k * 1024); } } while (0)
#define PG8_MMA(ai, bj, At, Bt) do { __builtin_amdgcn_s_setprio(1); _Pragma("unroll") for (int m = 0; m < 4; ++m) _Pragma("unroll") for (int n = 0; n < 2; ++n) { \
        if constexpr (FP8) asm volatile("v_mfma_scale_f32_16x16x128_f8f6f4 %0, %1, %2, %0, %3, %4 op_sel_hi:[0,0,0]" : "+v"(acc[ai][bj][m][n]) : "v"(Bt##8[n]), "v"(At##8[m]), "v"(scale_w), "v"(scale_x));     \
        else { _Pragma("unroll") for (int k = 0; k < 2; ++k) acc[ai][bj][m][n] = __builtin_amdgcn_mfma_f32_16x16x32_bf16(Bt[n][k], At[m][k], acc[ai][bj][m][n], 0, 0, 0); } } \
        __builtin_amdgcn_s_setprio(0); } while (0)
#define PG8_WAIT_V(n) asm volatile("s_waitcnt vmcnt(" #n ")" ::: "memory")
#define PG8_WAIT_L(n) asm volatile("s_waitcnt lgkmcnt(" #n ")" ::: "memory")
#define PG8_BAR __builtin_amdgcn_s_barrier()
#define PG8_SCHED __builtin_amdgcn_sched_barrier(0)
    Unit cur, nxt; int ui = 0;
    if (!S.next(0, cur)) return;
    if constexpr (ZERO) {
#pragma unroll
    for (int a = 0; a < 2; ++a)
#pragma unroll
        for (int b = 0; b < 2; ++b)
#pragma unroll
            for (int m = 0; m < 4; ++m)
#pragma unroll
                for (int n = 0; n < 2; ++n) acc[a][b][m][n] = (f32x4){0.f, 0.f, 0.f, 0.f};
    }
    bf16x8 At[4][2], B0[2][2], B1[2][2];
    const int scale_w = (int)(0x01010101u * (127u - WIN_SHIFT)), scale_x = (int)(0x01010101u * (127u - XSHIFT));
    pg8_v8i At8[4], B08[2], B18[2];
    const char* cA = (const char*)g.A + (size_t)cur.pm * tstep; const char* cB = (const char*)g.Bt + (size_t)cur.pn * tstep;
    S.a_ready(cur);
    if constexpr (SP2) {
        PG8_STAGE(PG8_SB(0, 0), cB, voffB); PG8_STAGE(PG8_SB(0, 1), cB + hstep, voffB); PG8_STAGE(PG8_SA(0, 0), cA, voffA); PG8_STAGE(PG8_SA(0, 1), cA + hstep, voffA);
        if (wr == 1) PG8_BAR;
        PG8_WAIT_V(2); PG8_BAR;
        PG8_STAGE(PG8_SB(1, 0), cB + kstep, voffB); PG8_STAGE(PG8_SA(1, 0), cA + kstep, voffA); PG8_STAGE(PG8_SB(1, 1), cB + hstep + kstep, voffB);
        PG8_WAIT_V(6); PG8_BAR;
    } else {
        PG8_STAGE(PG8_SB(0, 0), cB, voffB); PG8_STAGE(PG8_SA(0, 0), cA, voffA); PG8_STAGE(PG8_SB(0, 1), cB + hstep, voffB); PG8_STAGE(PG8_SA(0, 1), cA + hstep, voffA);
        if (wr == 1) PG8_BAR;
        PG8_WAIT_V(4); PG8_BAR;
        PG8_STAGE(PG8_SB(1, 0), cB + kstep, voffB); PG8_STAGE(PG8_SA(1, 0), cA + kstep, voffA); PG8_STAGE(PG8_SB(1, 1), cB + hstep + kstep, voffB);
        PG8_WAIT_V(6); PG8_BAR;
    }
    for (;;) {
        const bool has_next = S.next(ui + 1, nxt);
        const char* nA = has_next ? (const char*)g.A + (size_t)nxt.pm * tstep : cA; const char* nB = has_next ? (const char*)g.Bt + (size_t)nxt.pn * tstep : cB;
        for (int t = 0; t < nt; t += 2) {
            const bool last = (t == nt - 2);
            const char* a1 = cA + (size_t)(t + 1) * kstep;
            const char* a2 = last ? nA : cA + (size_t)(t + 2) * kstep; const char* b2 = last ? nB : cB + (size_t)(t + 2) * kstep;
            const char* a3 = a2 + kstep; const char* b3 = b2 + kstep;
            if (last && has_next) S.a_ready(nxt);
            if constexpr (SP2) {
            PG8_LDB(B0, 0, 0); PG8_LDB(B1, 0, 1); PG8_SCHED; PG8_LDA(At, 0, 0); PG8_STAGE(PG8_SA(1, 1), a1 + hstep, voffA);
            PG8_WAIT_V(8); PG8_WAIT_L(0); PG8_BAR; PG8_MMA(0, 0, At, B0); PG8_MMA(0, 1, At, B1); PG8_BAR; PG8_SCHED;
            PG8_LDA(At, 0, 1); PG8_STAGE(PG8_SB(0, 0), b2, voffB); PG8_STAGE(PG8_SB(0, 1), b2 + hstep, voffB); PG8_STAGE(PG8_SA(0, 0), a2, voffA);
            PG8_WAIT_V(8); PG8_WAIT_L(0); PG8_BAR; PG8_MMA(1, 0, At, B0); PG8_MMA(1, 1, At, B1); PG8_BAR; PG8_SCHED;
            PG8_LDB(B0, 1, 0); PG8_LDB(B1, 1, 1); PG8_SCHED; PG8_LDA(At, 1, 0); PG8_STAGE(PG8_SA(0, 1), a2 + hstep, voffA);
            PG8_WAIT_V(8); PG8_WAIT_L(0); PG8_BAR; PG8_MMA(0, 0, At, B0); PG8_MMA(0, 1, At, B1); PG8_BAR; PG8_SCHED;
            PG8_LDA(At, 1, 1); PG8_STAGE(PG8_SB(1, 0), b3, voffB); PG8_STAGE(PG8_SB(1, 1), b3 + hstep, voffB); PG8_STAGE(PG8_SA(1, 0), a3, voffA);
            PG8_WAIT_V(8); PG8_WAIT_L(0); PG8_BAR; PG8_MMA(1, 0, At, B0); PG8_MMA(1, 1, At, B1); PG8_BAR; PG8_SCHED;
            } else {
            PG8_LDB(B0, 0, 0); PG8_SCHED; PG8_LDA(At, 0, 0); PG8_STAGE(PG8_SA(1, 1), a1 + hstep, voffA);
            PG8_WAIT_L(8); PG8_BAR; PG8_WAIT_L(0); PG8_MMA(0, 0, At, B0); PG8_BAR; PG8_SCHED;
            PG8_LDB(B1, 0, 1); PG8_STAGE(PG8_SB(0, 0), b2, voffB);
            PG8_BAR; PG8_WAIT_L(0); PG8_MMA(0, 1, At, B1); PG8_BAR;
            PG8_LDA(At, 0, 1); PG8_STAGE(PG8_SA(0, 0), a2, voffA);
            PG8_BAR; PG8_WAIT_L(0); PG8_MMA(1, 0, At, B0); PG8_BAR; PG8_SCHED;
            PG8_STAGE(PG8_SB(0, 1), b2 + hstep, voffB);
            PG8_WAIT_V(6); PG8_BAR; PG8_MMA(1, 1, At, B1); PG8_BAR;
            PG8_LDB(B0, 1, 0); PG8_SCHED; PG8_LDA(At, 1, 0); PG8_STAGE(PG8_SA(0, 1), a2 + hstep, voffA);
            PG8_WAIT_L(8); PG8_BAR; PG8_WAIT_L(0); PG8_MMA(0, 0, At, B0); PG8_BAR; PG8_SCHED;
            PG8_LDB(B1, 1, 1); PG8_STAGE(PG8_SB(1, 0), b3, voffB);
            PG8_BAR; PG8_WAIT_L(0); PG8_MMA(0, 1, At, B1); PG8_BAR;
            PG8_LDA(At, 1, 1); PG8_STAGE(PG8_SA(1, 0), a3, voffA);
            PG8_BAR; PG8_WAIT_L(0); PG8_MMA(1, 0, At, B0); PG8_BAR; PG8_SCHED;
            PG8_STAGE(PG8_SB(1, 1), b3 + hstep, voffB);
            PG8_WAIT_V(6); PG8_BAR; PG8_MMA(1, 1, At, B1); PG8_BAR;
            }
        }
        if constexpr (ALIGN_EPI) { if (wr == 0) PG8_BAR; }
        if constexpr (FP8) asm volatile("s_nop 15\n\ts_nop 15" ::: "memory");
        if constexpr (!Epi::AFTER_DRAIN) { E(acc, cur, wr, wc, fr, fq); S.done(cur); }
        if (!has_next) break;
#pragma unroll
        for (int a = 0; a < 2; ++a)
#pragma unroll
            for (int b = 0; b < 2; ++b)
#pragma unroll
                for (int m = 0; m < 4; ++m)
#pragma unroll
                    for (int n = 0; n < 2; ++n) acc[a][b][m][n] = (f32x4){0.f, 0.f, 0.f, 0.f};
        cur = nxt; cA = nA; cB = nB; ++ui;
        if constexpr (ALIGN_EPI) { if (wr == 1) PG8_BAR; }
    }
    PG8_WAIT_V(0);
    if constexpr (!ALIGN_EPI) { if (wr == 0) PG8_BAR; }
    PG8_BAR;
    if constexpr (Epi::AFTER_DRAIN) { E.fused(acc, cur, wr, wc, fr, fq, lds, wid, lane); S.done(cur); }
#undef PG8_SA
#undef PG8_SB
#undef PG8_STAGE
#undef PG8_LDA
#undef PG8_LDB
#undef PG8_MMA
#undef PG8_LD8
#undef PG8_WAIT_V
#undef PG8_WAIT_L
#undef PG8_BAR
#undef PG8_SCHED
}
template <class Epi, class Sched, bool ALIGN_EPI = false, bool SP2 = false, bool FP8 = false, int XSHIFT = 0>
__device__ __forceinline__ void gemm_phase(PG8_LAS unsigned char* lds, const Gemm g, const Sched& S, const Epi& E, const int tid) {
    f32x4 acc[2][2][4][2];
    gemm_phase_acc<Epi, Sched, ALIGN_EPI, SP2, FP8, true, XSHIFT>(lds, g, S, E, tid, acc);
}
struct OneUnit {
    Unit u;
    __device__ __forceinline__ bool next(int i, Unit& o) const { if (i != 0) return false; o = u; return true; }
    __device__ __forceinline__ void a_ready(const Unit&) const {}
    __device__ __forceinline__ void done(const Unit&) const {}
};
}

struct StaticOrderConv : pg8::StaticOrder {
    int tpm, tpn, t2pm, t2pn, row0, rstride, rowend, wit0; const float* w_in; const float* w_ba; const float* w_bb; const float* w_out; unsigned char* w_in8; unsigned char* w_ba8; unsigned char* w_bb8; unsigned char* w_out8; const float* eu; const float* ev; unsigned char* eu6; unsigned char* ev6; float* scl; const float* gain;
    __device__ __forceinline__ void pick() { const int nfull = nwg / G, nu = (nwg - 1 - c) / G + 1; const int r = nu <= nfull ? nu - 1 : (c >> 3) % nfull; pg8::Unit t; next(r, t); tpm = t.pm; tpn = t.pn;
        const int r2 = nu <= nfull ? nu - 1 : (r + 2) % nfull; next(r2, t); t2pm = t.pm; t2pn = t.pn; }
    __device__ __forceinline__ void done(const pg8::Unit& u) const {
        if (u.pm == tpm && u.pn == tpn) {
            unsigned z_ = 0u; asm volatile("" : "+v"(z_));
            Ctx cc; cc.gw = row0; cc.ngw = rstride; cc.lane = (int)__builtin_amdgcn_mbcnt_hi(~0u, __builtin_amdgcn_mbcnt_lo(~0u, z_)); asm volatile("" : "+v"(cc.lane));
            convert_fp6_rows_b4(eu, eu6, scl, row0, 1, rowend, cc.lane, gain);
            convert_fp6_rows_b4(ev, ev6, scl + 1, row0, 1, rowend, cc.lane);
            asm volatile("s_waitcnt vmcnt(0)" ::: "memory");
        }
        if (wit0 >= 0 && u.pm == t2pm && u.pn == t2pn) {
            unsigned z_ = 0u; asm volatile("" : "+v"(z_));
            int ln = (int)__builtin_amdgcn_mbcnt_hi(~0u, __builtin_amdgcn_mbcnt_lo(~0u, z_)); asm volatile("" : "+v"(ln));
#pragma unroll 1
            for (int it = wit0; it < T64_LAYER; it += rstride) transpose_layer_item64(w_in, w_ba, w_bb, w_out, w_in8, w_ba8, w_bb8, w_out8, it, ln);
            asm volatile("s_waitcnt vmcnt(0)" ::: "memory");
        }
    }
};
constexpr int EX_OFF = MISC_OFF + 1024;
__device__ __forceinline__ float fast_sigmoid(float z) { return __builtin_amdgcn_rcpf(1.0f + __builtin_amdgcn_exp2f(-z * LOG2E)); }
__device__ __forceinline__ float rows_sum4(float v) {
    auto a = __builtin_amdgcn_permlane16_swap(__float_as_uint(v), __float_as_uint(v), false, false); v = __uint_as_float(a[0]) + __uint_as_float(a[1]);
    auto b = __builtin_amdgcn_permlane32_swap(__float_as_uint(v), __float_as_uint(v), false, false); return __uint_as_float(b[0]) + __uint_as_float(b[1]);
}
__device__ __forceinline__ int cls_row(int s) { return ((s & 15) << 7) | (s >> 4); }
__device__ __forceinline__ int cls_pos(int r) { return ((r & 127) << 4) | (r >> 7); }
struct EpiProjFused {
    static constexpr bool PERM = true, AFTER_DRAIN = false;
    bf16_t* Qo; bf16_t* Ko; bf16_t* Vo; bf16_t* gate; const float* qn; const float* kn; const float* rot; LAS unsigned char* lds; const float* bg;
    __device__ __forceinline__ void operator()(const pg8::f32x4 (&acc)[2][2][4][2], const pg8::Unit& u, int wr, int wc, int fr, int fq) const {
        const int row0 = u.pm * 256 + wr * 64 + fr;
        if (u.pn >= QKV_COLS / 256) {
            const int col0 = (u.pn - QKV_COLS / 256) * 256 + wc * 32 + 8 * fq;
            pg8::f32x4 bia[2][2];
#pragma unroll
            for (int bj = 0; bj < 2; ++bj) { bia[bj][0] = *(const pg8::f32x4*)(bg + col0 + bj * 128); bia[bj][1] = *(const pg8::f32x4*)(bg + col0 + bj * 128 + 4); }
#pragma unroll
            for (int ai = 0; ai < 2; ++ai)
#pragma unroll
                for (int m = 0; m < 4; ++m) { unsigned char* rowp = (unsigned char*)gate + (size_t)(row0 + ai * 128 + m * 16) * (2 * DM) + col0;
#pragma unroll
                    for (int bj = 0; bj < 2; ++bj) { constexpr float GS = (float)(1 << GATE_SHIFT); const pg8::f32x4 v0 = (acc[ai][bj][m][0] + bia[bj][0]) * GS, v1 = (acc[ai][bj][m][1] + bia[bj][1]) * GS;
                        int w0 = __builtin_amdgcn_cvt_pk_fp8_f32(v0[0], v0[1], 0, false); w0 = __builtin_amdgcn_cvt_pk_fp8_f32(v0[2], v0[3], w0, true);
                        int w1 = __builtin_amdgcn_cvt_pk_fp8_f32(v1[0], v1[1], 0, false); w1 = __builtin_amdgcn_cvt_pk_fp8_f32(v1[2], v1[3], w1, true);
                        *(v2u*)(rowp + bj * 128) = (v2u){(unsigned)w0, (unsigned)w1}; } }
            return;
        }
        const int sel = u.pn / 10, hp = 2 * (u.pn % 10), qd = 4 * wc + fq;
        const bool cls = hp >= 8 && hp < DIL_HEADS;
        if (sel == 2) {
#pragma unroll
            for (int ai = 0; ai < 2; ++ai)
#pragma unroll
                for (int m = 0; m < 4; ++m) { const int row = row0 + ai * 128 + m * 16, b = row >> 11, sq0 = row & (SEQ - 1), sq = cls ? cls_row(sq0) : sq0;
#pragma unroll
                    for (int bj = 0; bj < 2; ++bj) { const pg8::f32x4 v0 = acc[ai][bj][m][0], v1 = acc[ai][bj][m][1];
                        int w0 = __builtin_amdgcn_cvt_pk_fp8_f32(v0[0], v0[1], 0, false); w0 = __builtin_amdgcn_cvt_pk_fp8_f32(v0[2], v0[3], w0, true);
                        int w1 = __builtin_amdgcn_cvt_pk_fp8_f32(v1[0], v1[1], 0, false); w1 = __builtin_amdgcn_cvt_pk_fp8_f32(v1[2], v1[3], w1, true);
                        *(v2u*)((unsigned char*)Vo + (((size_t)b * NHEADS + hp + bj) * SEQ + sq) * HD + 8 * qd) = (v2u){(unsigned)w0, (unsigned)w1}; } }
            return;
        }
        LAS float* ex = (LAS float*)(lds + EX_OFF);
        const float* gn = sel == 0 ? qn : kn; bf16_t* dst = sel == 0 ? Qo : Ko; const float osc = sel == 0 ? QSCALE : 1.0f;
        const bool dil = hp < DIL_HEADS;
        pg8::f32x4 g1[2], g2[2], cs[2][4], sn[2][4];
#pragma unroll
        for (int bj = 0; bj < 2; ++bj) { g1[bj] = *(const pg8::f32x4*)(gn + (hp + bj) * HD + 4 * qd); g2[bj] = *(const pg8::f32x4*)(gn + (hp + bj) * HD + 64 + 4 * qd); }
        const float* rotp = rot + (size_t)((u.pm * 256 + wr * 64 + fr) & (SEQ - 1)) * 64 + 4 * qd;
#define EPF_ROT(k_) do { cs[(k_) >> 2][(k_) & 3] = *(const pg8::f32x4*)(rotp + (((k_) >> 2) * 128 + ((k_) & 3) * 16) * 64); sn[(k_) >> 2][(k_) & 3] = *(const pg8::f32x4*)(rotp + SEQ * 64 + (((k_) >> 2) * 128 + ((k_) & 3) * 16) * 64); } while (0)
        if (dil) { EPF_ROT(0); EPF_ROT(1); EPF_ROT(2); }
        asm volatile("" ::: "memory");
#pragma unroll
        for (int ai = 0; ai < 2; ++ai)
#pragma unroll
            for (int m = 0; m < 4; ++m)
#pragma unroll
                for (int bj = 0; bj < 2; ++bj) { const pg8::f32x4 v0 = acc[ai][bj][m][0], v1 = acc[ai][bj][m][1];
                    float ss = (v0[0] * v0[0] + v0[1] * v0[1]) + (v0[2] * v0[2] + v0[3] * v0[3]) + (v1[0] * v1[0] + v1[1] * v1[1]) + (v1[2] * v1[2] + v1[3] * v1[3]);
                    ss = rows_sum4(ss);
                    if (fq == 0) ex[((ai * 128 + wr * 64 + m * 16 + fr) * 2 + bj) * 4 + wc] = ss; }
        asm volatile("s_waitcnt lgkmcnt(0)" ::: "memory"); __builtin_amdgcn_s_barrier(); asm volatile("" ::: "memory");
#pragma unroll
        for (int ai = 0; ai < 2; ++ai)
#pragma unroll
            for (int m = 0; m < 4; ++m) { const int rl = ai * 128 + wr * 64 + m * 16 + fr, row = u.pm * 256 + rl, b = row >> 11, sq = row & (SEQ - 1);
                asm volatile("" ::: "memory");
                if (ai * 4 + m + 3 < 8 && dil) { EPF_ROT(ai * 4 + m + 3); asm volatile("" ::: "memory"); }
#pragma unroll
                for (int bj = 0; bj < 2; ++bj) { const int head = hp + bj;
                    const pg8::f32x4 e = *(const LAS pg8::f32x4*)(ex + (rl * 2 + bj) * 4);
                    const float rstd = osc * __builtin_amdgcn_rsqf(((e[0] + e[1]) + (e[2] + e[3])) * (1.0f / HD) + RMS_EPS);
                    pg8::f32x4 y1 = acc[ai][bj][m][0] * rstd * g1[bj], y2 = acc[ai][bj][m][1] * rstd * g2[bj];
                    if (dil) { const pg8::f32x4 o1 = y1 * cs[ai][m] - y2 * sn[ai][m], o2 = y2 * cs[ai][m] + y1 * sn[ai][m]; y1 = o1; y2 = o2; }
                    const size_t eo = (((size_t)b * NHEADS + head) * SEQ + (cls ? cls_row(sq) : sq)) * HD + 4 * qd;
                    if (sel == 0) { bf16_t* rp = dst + eo;
                        v2u w1, w2; w1.x = pg8::cvt_pk_bf16(y1[0], y1[1]); w1.y = pg8::cvt_pk_bf16(y1[2], y1[3]); w2.x = pg8::cvt_pk_bf16(y2[0], y2[1]); w2.y = pg8::cvt_pk_bf16(y2[2], y2[3]);
                        *(v2u*)rp = w1; *(v2u*)(rp + 64) = w2; }
                    else { unsigned char* rp = (unsigned char*)dst + eo;
                        int p1 = __builtin_amdgcn_cvt_pk_fp8_f32(y1[0], y1[1], 0, false); p1 = __builtin_amdgcn_cvt_pk_fp8_f32(y1[2], y1[3], p1, true);
                        int p2 = __builtin_amdgcn_cvt_pk_fp8_f32(y2[0], y2[1], 0, false); p2 = __builtin_amdgcn_cvt_pk_fp8_f32(y2[2], y2[3], p2, true);
                        *(unsigned*)rp = (unsigned)p1; *(unsigned*)(rp + 64) = (unsigned)p2; } } }
#undef EPF_ROT
    }
};
struct EpiBf16F {
    static constexpr bool PERM = true, AFTER_DRAIN = false;
    bf16_t* O; int ldc;
    __device__ __forceinline__ void operator()(const pg8::f32x4 (&acc)[2][2][4][2], const pg8::Unit& u, int wr, int wc, int fr, int fq) const {
        const int row0 = u.pm * 256 + wr * 64 + fr, col0 = u.pn * 256 + wc * 32 + 8 * fq;
#pragma unroll
        for (int ai = 0; ai < 2; ++ai)
#pragma unroll
            for (int m = 0; m < 4; ++m) { bf16_t* rowp = O + (size_t)(row0 + ai * 128 + m * 16) * ldc + col0;
#pragma unroll
                for (int bj = 0; bj < 2; ++bj) { const pg8::f32x4 v0 = acc[ai][bj][m][0], v1 = acc[ai][bj][m][1];
                    pg8::u32x4 w; w.x = pg8::cvt_pk_bf16(v0[0], v0[1]); w.y = pg8::cvt_pk_bf16(v0[2], v0[3]); w.z = pg8::cvt_pk_bf16(v1[0], v1[1]); w.w = pg8::cvt_pk_bf16(v1[2], v1[3]);
                    *(pg8::u32x4*)(rowp + bj * 128) = w; } }
    }
};
__device__ __forceinline__ float sig_den(float z) { return 1.0f + __builtin_amdgcn_exp2f(fminf(-z * LOG2E, 64.0f)); }
struct EpiBranchScale {
    static constexpr bool PERM = true, AFTER_DRAIN = false;
    const bf16_t* gate;
    __device__ __forceinline__ void operator()(pg8::f32x4 (&acc)[2][2][4][2], const pg8::Unit& u, int wr, int wc, int fr, int fq) const {
        constexpr float GI = 1.0f / (float)(1 << GATE_SHIFT);
        const unsigned char* gp = (const unsigned char*)gate + (size_t)(u.pm * 256 + wr * 64 + fr) * (2 * DM) + (u.pn * 256 + wc * 32 + 8 * fq);
#pragma unroll
        for (int ai = 0; ai < 2; ++ai)
#pragma unroll
            for (int m = 0; m < 4; ++m) {
                const unsigned char* ga_p = gp + (size_t)(ai * 128 + m * 16) * (2 * DM); const unsigned char* gb_p = ga_p + DM;
                asm volatile("" : "+v"(ga_p), "+v"(gb_p) :: "memory");
#pragma unroll
                for (int bj = 0; bj < 2; ++bj) {
                    asm volatile("" ::: "memory");
                    const v2u ga = *(const v2u*)(ga_p + bj * 128), gb = *(const v2u*)(gb_p + bj * 128);
                    const auto a0 = __builtin_amdgcn_cvt_pk_f32_fp8((int)ga.x, false), a1 = __builtin_amdgcn_cvt_pk_f32_fp8((int)ga.x, true), a2 = __builtin_amdgcn_cvt_pk_f32_fp8((int)ga.y, false), a3 = __builtin_amdgcn_cvt_pk_f32_fp8((int)ga.y, true);
                    const auto b0 = __builtin_amdgcn_cvt_pk_f32_fp8((int)gb.x, false), b1 = __builtin_amdgcn_cvt_pk_f32_fp8((int)gb.x, true), b2 = __builtin_amdgcn_cvt_pk_f32_fp8((int)gb.y, false), b3 = __builtin_amdgcn_cvt_pk_f32_fp8((int)gb.y, true);
#define EBS_R(ga_, gb_) (sig_den((gb_) * GI) * fast_sigmoid((ga_) * GI))
                    acc[ai][bj][m][0][0] *= EBS_R(a0[0], b0[0]); acc[ai][bj][m][0][1] *= EBS_R(a0[1], b0[1]);
                    acc[ai][bj][m][0][2] *= EBS_R(a1[0], b1[0]); acc[ai][bj][m][0][3] *= EBS_R(a1[1], b1[1]);
                    acc[ai][bj][m][1][0] *= EBS_R(a2[0], b2[0]); acc[ai][bj][m][1][1] *= EBS_R(a2[1], b2[1]);
                    acc[ai][bj][m][1][2] *= EBS_R(a3[0], b3[0]); acc[ai][bj][m][1][3] *= EBS_R(a3[1], b3[1]);
#undef EBS_R
                    asm volatile("" : "+v"(acc[ai][bj][m][0]), "+v"(acc[ai][bj][m][1]));
                } }
    }
};
struct EpiBranchOut {
    static constexpr bool PERM = true, AFTER_DRAIN = false;
    bf16_t* merged; const bf16_t* gate;
    __device__ __forceinline__ void operator()(const pg8::f32x4 (&acc)[2][2][4][2], const pg8::Unit& u, int wr, int wc, int fr, int fq) const {
        const int row0 = u.pm * 256 + wr * 64 + fr, col0 = u.pn * 256 + wc * 32 + 8 * fq;
#pragma unroll
        for (int ai = 0; ai < 2; ++ai)
#pragma unroll
            for (int m = 0; m < 4; ++m) { const size_t row = (size_t)(row0 + ai * 128 + m * 16);
#pragma unroll
                for (int bj = 0; bj < 2; ++bj) { const int c = col0 + bj * 128;
                    asm volatile("" ::: "memory");
                    const v2u gl = *(const v2u*)((const unsigned char*)gate + row * (2 * DM) + c);
                    const auto g0 = __builtin_amdgcn_cvt_pk_f32_fp8((int)gl.x, false), g1 = __builtin_amdgcn_cvt_pk_f32_fp8((int)gl.x, true), g2 = __builtin_amdgcn_cvt_pk_f32_fp8((int)gl.y, false), g3 = __builtin_amdgcn_cvt_pk_f32_fp8((int)gl.y, true);
                    constexpr float GI = 1.0f / (float)(1 << GATE_SHIFT);
#define EBO_S(g_) __builtin_amdgcn_rcpf(sig_den((g_) * GI))
                    pg8::f32x4 o0, o1;
                    o0[0] = EBO_S(g0[0]) * acc[ai][bj][m][0][0]; o0[1] = EBO_S(g0[1]) * acc[ai][bj][m][0][1];
                    o0[2] = EBO_S(g1[0]) * acc[ai][bj][m][0][2]; o0[3] = EBO_S(g1[1]) * acc[ai][bj][m][0][3];
                    o1[0] = EBO_S(g2[0]) * acc[ai][bj][m][1][0]; o1[1] = EBO_S(g2[1]) * acc[ai][bj][m][1][1];
                    o1[2] = EBO_S(g3[0]) * acc[ai][bj][m][1][2]; o1[3] = EBO_S(g3[1]) * acc[ai][bj][m][1][3];
#undef EBO_S
                    constexpr float MS = (float)(1 << MRG_SHIFT);
                    int w0 = __builtin_amdgcn_cvt_pk_fp8_f32(o0[0] * MS, o0[1] * MS, 0, false); w0 = __builtin_amdgcn_cvt_pk_fp8_f32(o0[2] * MS, o0[3] * MS, w0, true);
                    int w1 = __builtin_amdgcn_cvt_pk_fp8_f32(o1[0] * MS, o1[1] * MS, 0, false); w1 = __builtin_amdgcn_cvt_pk_fp8_f32(o1[2] * MS, o1[3] * MS, w1, true);
                    *(v2u*)((unsigned char*)merged + row * DM + c) = (v2u){(unsigned)w0, (unsigned)w1}; } }
    }
};
template <bool XB16>
struct EpiResidualNorm {
    static constexpr bool PERM = true, AFTER_DRAIN = false;
    const float* xin; bf16_t* xb; float* partss; LAS unsigned char* lds; unsigned char* x8;
    __device__ __forceinline__ void operator()(const pg8::f32x4 (&acc)[2][2][4][2], const pg8::Unit& u, int wr, int wc, int fr, int fq) const {
        const int row0 = u.pm * 256 + wr * 64 + fr, col0 = u.pn * 256 + wc * 32 + 8 * fq;
        LAS float* ex = (LAS float*)(lds + EX_OFF);
#pragma unroll
        for (int ai = 0; ai < 2; ++ai)
#pragma unroll
            for (int m = 0; m < 4; ++m) { const size_t o = (size_t)(row0 + ai * 128 + m * 16) * DM + col0; float ss = 0.f;
#pragma unroll
                for (int bj = 0; bj < 2; ++bj) {
                    asm volatile("" ::: "memory");
                    pg8::f32x4 a, b;
                    if (XB16) { const pg8::u32x4 w_ = *(const pg8::u32x4*)((const bf16_t*)xin + o + bj * 128); a = (pg8::f32x4){bflo(w_.x), bfhi(w_.x), bflo(w_.y), bfhi(w_.y)}; b = (pg8::f32x4){bflo(w_.z), bfhi(w_.z), bflo(w_.w), bfhi(w_.w)}; }
                    else { a = *(const pg8::f32x4*)(xin + o + bj * 128); b = *(const pg8::f32x4*)(xin + o + bj * 128 + 4); }
                    const pg8::f32x4 x0 = a + acc[ai][bj][m][0], x1v = b + acc[ai][bj][m][1];
                    ss += (x0[0] * x0[0] + x0[1] * x0[1]) + (x0[2] * x0[2] + x0[3] * x0[3]) + (x1v[0] * x1v[0] + x1v[1] * x1v[1]) + (x1v[2] * x1v[2] + x1v[3] * x1v[3]);
                    pg8::u32x4 w; w.x = pg8::cvt_pk_bf16(x0[0], x0[1]); w.y = pg8::cvt_pk_bf16(x0[2], x0[3]); w.z = pg8::cvt_pk_bf16(x1v[0], x1v[1]); w.w = pg8::cvt_pk_bf16(x1v[2], x1v[3]);
                    *(pg8::u32x4*)(xb + o + bj * 128) = w;
                    { constexpr float XS = (float)(1 << X1_SHIFT);
                      int w0 = __builtin_amdgcn_cvt_pk_fp8_f32(x0[0] * XS, x0[1] * XS, 0, false); w0 = __builtin_amdgcn_cvt_pk_fp8_f32(x0[2] * XS, x0[3] * XS, w0, true);
                      int w1 = __builtin_amdgcn_cvt_pk_fp8_f32(x1v[0] * XS, x1v[1] * XS, 0, false); w1 = __builtin_amdgcn_cvt_pk_fp8_f32(x1v[2] * XS, x1v[3] * XS, w1, true);
                      *(v2u*)(x8 + o + bj * 128) = (v2u){(unsigned)w0, (unsigned)w1}; }
 }
                ss = rows_sum4(ss);
                if (fq == 0) ex[(ai * 128 + wr * 64 + m * 16 + fr) * 4 + wc] = ss; }
        asm volatile("s_waitcnt lgkmcnt(0)" ::: "memory"); __builtin_amdgcn_s_barrier(); asm volatile("" ::: "memory");
        if (wc == 0 && fq == 0) {
#pragma unroll
            for (int ai = 0; ai < 2; ++ai)
#pragma unroll
                for (int m = 0; m < 4; ++m) { const int rl = ai * 128 + wr * 64 + m * 16 + fr; const pg8::f32x4 e = *(const LAS pg8::f32x4*)(ex + rl * 4);
                    partss[(size_t)(u.pm * 256 + rl) * 8 + u.pn] = (e[0] + e[1]) + (e[2] + e[3]); }
        }
    }
};
__device__ __forceinline__ float row_rstd(const float* partss, int row) {
    const f32x4 a = *(const f32x4*)(partss + (size_t)row * 8), b = *(const f32x4*)(partss + (size_t)row * 8 + 4);
    return __builtin_amdgcn_rsqf((((a.x + a.y) + (a.z + a.w)) + ((b.x + b.y) + (b.z + b.w))) * (1.0f / DM) + RMS_EPS);
}
struct EpiBf16RowScale {
    static constexpr bool PERM = true, AFTER_DRAIN = false;
    bf16_t* O; int ldc; const float* partss;
    __device__ __forceinline__ void operator()(const pg8::f32x4 (&acc)[2][2][4][2], const pg8::Unit& u, int wr, int wc, int fr, int fq) const {
        const int row0 = u.pm * 256 + wr * 64 + fr, col0 = u.pn * 256 + wc * 32 + 8 * fq;
#pragma unroll
        for (int ai = 0; ai < 2; ++ai)
#pragma unroll
            for (int m = 0; m < 4; ++m) { const int row = row0 + ai * 128 + m * 16; const float rs = row_rstd(partss, row); bf16_t* rowp = O + (size_t)row * ldc + col0;
#pragma unroll
                for (int bj = 0; bj < 2; ++bj) { const pg8::f32x4 v0 = acc[ai][bj][m][0], v1 = acc[ai][bj][m][1];
                    pg8::u32x4 w; w.x = pg8::cvt_pk_bf16(v0[0] * rs, v0[1] * rs); w.y = pg8::cvt_pk_bf16(v0[2] * rs, v0[3] * rs); w.z = pg8::cvt_pk_bf16(v1[0] * rs, v1[1] * rs); w.w = pg8::cvt_pk_bf16(v1[2] * rs, v1[3] * rs);
                    *(pg8::u32x4*)(rowp + bj * 128) = w; } }
    }
};

__device__ __forceinline__ void decay_cumsum(const float* logf, float* kbias, float* zbias, const Ctx& c) {
    const int gwr = c.ngw - 1 - c.gw;
    if (blockIdx.x == gridDim.x - 1) for (int i = c.tid; i < SEQ; i += NTHREADS) zbias[i] = 0.f;
    if (gwr < NBATCH * FOX_HEADS) {
        const int b = gwr / FOX_HEADS, h = gwr % FOX_HEADS;
        float loc[32]; float run = 0.f;
#pragma unroll
        for (int i = 0; i < 32; ++i) { run += logf[((size_t)b * SEQ + c.lane * 32 + i) * 8 + h]; loc[i] = run; }
        float incl = run;
#pragma unroll
        for (int o = 1; o < 64; o <<= 1) { const float t = __shfl_up(incl, o); if (c.lane >= o) incl += t; }
        const float excl = incl - run;
#pragma unroll
        for (int i = 0; i < 32; ++i) kbias[((size_t)b * FOX_HEADS + h) * SEQ + c.lane * 32 + i] = -(excl + loc[i]) * LOG2E;
    }
}
__device__ __forceinline__ void phase_prep(const bf16_t* proj, const float* qn_l, const float* kn_l, bf16_t* Qo, bf16_t* Ko, bf16_t* Vo, const float* logf, float* kbias, float* zbias, const Ctx& c) {
    if (blockIdx.x == 0) for (int i = c.tid; i < SEQ; i += NTHREADS) zbias[i] = 0.f;
    const float inv_freq = exp2f(-(float)c.lane * (13.287712379549449f / 64.0f));
    for (int it = c.gw; it < T * NHEADS; it += c.ngw) {
        const int row = it / NHEADS, h = it - row * NHEADS, b = row / SEQ, s = row - b * SEQ;
        const bf16_t* pr = proj + (size_t)row * QKV_COLS + h * HD;
        float q1 = bf2f(pr[c.lane]), q2 = bf2f(pr[c.lane + 64]);
        float k1 = bf2f(pr[NHEADS * HD + c.lane]), k2 = bf2f(pr[NHEADS * HD + c.lane + 64]);
        const bf16_t v1 = pr[2 * NHEADS * HD + c.lane], v2 = pr[2 * NHEADS * HD + c.lane + 64];
        const float qr = 1.0f / sqrtf(wave_sum(q1 * q1 + q2 * q2) * (1.0f / HD) + RMS_EPS);
        const float kr = 1.0f / sqrtf(wave_sum(k1 * k1 + k2 * k2) * (1.0f / HD) + RMS_EPS);
        q1 *= qr * qn_l[h * HD + c.lane]; q2 *= qr * qn_l[h * HD + c.lane + 64];
        k1 *= kr * kn_l[h * HD + c.lane]; k2 *= kr * kn_l[h * HD + c.lane + 64];
        if (h < DIL_HEADS) {
            float sn, cs; sincosf((float)s * inv_freq, &sn, &cs);
            const float a = q1 * cs - q2 * sn, bq = q2 * cs + q1 * sn; q1 = a; q2 = bq;
            const float ck = k1 * cs - k2 * sn, dk = k2 * cs + k1 * sn; k1 = ck; k2 = dk;
        }
        const size_t o = (((size_t)b * NHEADS + h) * SEQ + s) * HD;
        Qo[o + c.lane] = (bf16_t)f2bf(q1 * QSCALE); Qo[o + c.lane + 64] = (bf16_t)f2bf(q2 * QSCALE);
        Ko[o + c.lane] = (bf16_t)f2bf(k1); Ko[o + c.lane + 64] = (bf16_t)f2bf(k2);
        Vo[o + c.lane] = v1; Vo[o + c.lane + 64] = v2;
    }
    if (c.gw < NBATCH * FOX_HEADS) {
        const int b = c.gw / FOX_HEADS, h = c.gw % FOX_HEADS;
        float loc[32]; float run = 0.f;
#pragma unroll
        for (int i = 0; i < 32; ++i) { run += logf[((size_t)b * SEQ + c.lane * 32 + i) * 8 + h]; loc[i] = run; }
        float incl = run;
#pragma unroll
        for (int o = 1; o < 64; o <<= 1) { const float t = __shfl_up(incl, o); if (c.lane >= o) incl += t; }
        const float excl = incl - run;
#pragma unroll
        for (int i = 0; i < 32; ++i) kbias[((size_t)b * FOX_HEADS + h) * SEQ + c.lane * 32 + i] = -(excl + loc[i]) * LOG2E;
    }
}

__device__ __forceinline__ void attn_step(float sc, unsigned vw, float& m, float& l, float& o0, float& o1) {
    const float mn = fmaxf(m, sc), al = exp2f(m - mn), p = exp2f(sc - mn);
    l = l * al + p; o0 = o0 * al + p * bflo(vw); o1 = o1 * al + p * bfhi(vw); m = mn;
}
__device__ __forceinline__ void phase_attn_naive(const bf16_t* Q, const bf16_t* K, const bf16_t* V, const float* kbias, bf16_t* oa, bf16_t* ob, const Ctx& c) {
    constexpr int NA = NBATCH * 4 * SEQ, NBI = NBATCH * FOX_HEADS * SEQ;
    for (int it = c.gw; it < NA + NBI; it += c.ngw) {
        float m = -1e30f, l = 0.f, o0 = 0.f, o1 = 0.f;
        if (it < NA) {
            const int b = it / (4 * SEQ), r = it - b * 4 * SEQ, slot = r / SEQ, t = r - slot * SEQ;
#pragma unroll 1
            for (int g = 0; g < 3; ++g) {
                const int dil = g == 0 ? 1 : g == 1 ? 4 : 16, head = g * 4 + slot;
                const size_t hb = ((size_t)b * NHEADS + head) * SEQ;
                const unsigned qw = ((const unsigned*)(Q + (hb + t) * HD))[c.lane];
                for (int j = 0; j <= 128; ++j) {
                    const int s = t - j * dil; if (s < 0) break;
                    const unsigned kw = ((const unsigned*)(K + (hb + s) * HD))[c.lane];
                    const unsigned vw = ((const unsigned*)(V + (hb + s) * HD))[c.lane];
                    const float sc = wave_sum(dot2(qw, kw, 0.f));
                    attn_step(sc, vw, m, l, o0, o1);
                }
            }
            const float il = 1.0f / l;
            ((unsigned*)(oa + ((size_t)b * SEQ + t) * A_OUT + slot * HD))[c.lane] = pk2(o0 * il, o1 * il);
        } else {
            const int i2 = it - NA, b = i2 / (FOX_HEADS * SEQ), r = i2 - b * FOX_HEADS * SEQ, h = r / SEQ, t = r - h * SEQ;
            const size_t hb = ((size_t)b * NHEADS + DIL_HEADS + h) * SEQ;
            const float* kb = kbias + ((size_t)b * FOX_HEADS + h) * SEQ;
            const unsigned qw = ((const unsigned*)(Q + (hb + t) * HD))[c.lane];
            for (int s = 0; s <= t; ++s) {
                const unsigned kw = ((const unsigned*)(K + (hb + s) * HD))[c.lane];
                const unsigned vw = ((const unsigned*)(V + (hb + s) * HD))[c.lane];
                const float sc = wave_sum(dot2(qw, kw, 0.f)) + kb[s];
                attn_step(sc, vw, m, l, o0, o1);
            }
            const float il = 1.0f / l;
            ((unsigned*)(ob + ((size_t)b * SEQ + t) * B_OUT + h * HD))[c.lane] = pk2(o0 * il, o1 * il);
        }
    }
}

namespace att {
constexpr int D = 128, NW = 8, QBLK = 32, KVBLK = 64, QB = NW * QBLK;
constexpr int SHM_V = KVBLK * D * 2, SHM_K = KVBLK * D * 2;
constexpr int OFF_WS = 2 * SHM_V + 2 * SHM_K, OFF_BIAS = OFF_WS + NW * 64 * 4, LDS_BYTES_ATT = OFF_BIAS + 2 * KVBLK * 4;
constexpr float THR2 = 8.f * 1.4426950408889634f;
typedef unsigned short bf16;
typedef short bf16x8 __attribute__((ext_vector_type(8)));
typedef short s16x4 __attribute__((ext_vector_type(4)));
typedef float f32x16 __attribute__((ext_vector_type(16)));
typedef float f32x4 __attribute__((ext_vector_type(4)));
typedef unsigned u32x4 __attribute__((ext_vector_type(4)));
#define KSWZ(row, colB) ((row) * 256 + ((colB) ^ (((row) & 7) << 4)))
#define SBAR() __builtin_amdgcn_sched_barrier(0)
__device__ __forceinline__ int v_st(int k, int c) { const int kk = (k & ~0xC) | ((k & 4) << 1) | ((k & 8) >> 1); return ((kk >> 3) * 4 + (c >> 5)) * 512 + ((kk & 7) * 32 + (c & 31)) * 2; }
__device__ __forceinline__ int v_rd_base(int lane) { return ((lane & 3) << 3) | (((lane >> 2) & 3) << 6) | (((lane >> 4) & 1) << 5) | (((lane >> 5) & 1) << 8); }
constexpr int v_rd_off(int d0, int ks, int half) { return d0 * 512 + ks * 4096 + half * 2048; }
__device__ __forceinline__ int crow(int r, int hi) { return (r & 3) + 8 * (r >> 2) + 4 * hi; }
__device__ __forceinline__ unsigned cvtpk(float lo, float hi) { unsigned r; asm volatile("v_cvt_pk_bf16_f32 %0, %1, %2" : "=v"(r) : "v"(lo), "v"(hi)); return r; }
__device__ __forceinline__ bf16x8 load8(const bf16* p) { return *reinterpret_cast<const bf16x8*>(p); }
template <bool DIL>
__device__ __forceinline__ void mask_tile(f32x16& p0, f32x16& p1, int dq, unsigned W, int dmask) {
    const float NEG = -__builtin_inff();
#pragma unroll
    for (int r = 0; r < 16; ++r) {
        const int c = (r & 3) + 8 * (r >> 2);
        const int d0 = dq - c, d1 = dq - c - 32;
        if ((unsigned)d0 >= W || (DIL && (d0 & dmask))) p0[r] = NEG;
        if ((unsigned)d1 >= W || (DIL && (d1 & dmask))) p1[r] = NEG;
    }
}
__device__ __forceinline__ void partialSM(f32x16& p0, f32x16& p1, float& m_reg, float& mn, float& alpha) {
    float pmax = p0[0]; for (int r = 1; r < 16; ++r) pmax = fmaxf(pmax, p0[r]); for (int r = 0; r < 16; ++r) pmax = fmaxf(pmax, p1[r]);
    { auto rr = __builtin_amdgcn_permlane32_swap(__float_as_uint(pmax), __float_as_uint(pmax), false, false);
      pmax = fmaxf(__uint_as_float(rr[0]), __uint_as_float(rr[1])); }
    if (__builtin_expect(__all((pmax - m_reg) <= THR2), 1)) { mn = m_reg; alpha = 1.f; }
    else { mn = fmaxf(m_reg, pmax); alpha = __builtin_amdgcn_exp2f(m_reg - mn); m_reg = mn; }
    for (int r = 0; r < 16; ++r) p0[r] = p0[r] - mn; for (int r = 0; r < 16; ++r) p1[r] = p1[r] - mn;
    for (int r = 0; r < 16; ++r) p0[r] = __builtin_amdgcn_exp2f(p0[r]);
}
__device__ __forceinline__ void finishSM(f32x16& p0, f32x16& p1, float alpha, float& l_reg, bf16x8& pa0, bf16x8& pa1, bf16x8& pa2, bf16x8& pa3) {
    for (int r = 0; r < 16; ++r) p1[r] = __builtin_amdgcn_exp2f(p1[r]);
    float ps = 0; for (int r = 0; r < 16; ++r) ps += p0[r]; for (int r = 0; r < 16; ++r) ps += p1[r];
    { auto rr = __builtin_amdgcn_permlane32_swap(__float_as_uint(ps), __float_as_uint(ps), false, false);
      ps = __uint_as_float(rr[0]) + __uint_as_float(rr[1]); }
    l_reg = l_reg * alpha + ps;
#define PK4(P, B_, OUT) do { unsigned a0 = cvtpk(P[B_+0], P[B_+1]), a1 = cvtpk(P[B_+2], P[B_+3]);                          \
        unsigned b0 = cvtpk(P[B_+4], P[B_+5]), b1 = cvtpk(P[B_+6], P[B_+7]);                                             \
        auto r0 = __builtin_amdgcn_permlane32_swap(a0, b0, false, false); auto r1 = __builtin_amdgcn_permlane32_swap(a1, b1, false, false); \
        u32x4 w = {r0[0], r1[0], r0[1], r1[1]}; OUT = *reinterpret_cast<bf16x8*>(&w); } while (0)
    PK4(p0, 0, pa0); PK4(p0, 8, pa1); PK4(p1, 0, pa2); PK4(p1, 8, pa3);
#undef PK4
}
template <int KB>
__device__ __forceinline__ void qkt(f32x16& p0, f32x16& p1, const char* K_lds, const char* B_lds, int r32, int hi, const bf16x8* qr) {
    const char* bl = B_lds + KB * (KVBLK * 4) + hi * 16;
#pragma unroll
    for (int g = 0; g < 4; ++g) { const f32x4 b0 = *reinterpret_cast<const f32x4*>(bl + g * 32), b1 = *reinterpret_cast<const f32x4*>(bl + 128 + g * 32);
        p0[4 * g] = b0[0]; p0[4 * g + 1] = b0[1]; p0[4 * g + 2] = b0[2]; p0[4 * g + 3] = b0[3];
        p1[4 * g] = b1[0]; p1[4 * g + 1] = b1[1]; p1[4 * g + 2] = b1[2]; p1[4 * g + 3] = b1[3]; }
    const char* kb[4];
#pragma unroll
    for (int dd = 0; dd < 4; ++dd) kb[dd] = K_lds + KB * SHM_K + KSWZ(r32, (dd * 16 + hi * 8) * 2);
#pragma unroll
    for (int d0 = 0; d0 < 8; ++d0) { const char* a = kb[d0 & 3] + (d0 >> 2) * 128;
        bf16x8 b0 = *reinterpret_cast<const bf16x8*>(a);
        bf16x8 b1 = *reinterpret_cast<const bf16x8*>(a + 32 * 256);
        p0 = __builtin_amdgcn_mfma_f32_32x32x16_bf16(b0, qr[d0], p0, 0, 0, 0);
        p1 = __builtin_amdgcn_mfma_f32_32x32x16_bf16(b1, qr[d0], p1, 0, 0, 0); }
}
template <int VB>
__device__ __forceinline__ void pv_tile(f32x16* o, int vb0, bf16x8 pa0, bf16x8 pa1, bf16x8 pa2, bf16x8 pa3) {
#define TRRD(dst, off) asm volatile("ds_read_b64_tr_b16 %0, %1 offset:%2" : "=&v"(dst) : "v"(vb0), "i"(off) : "memory")
#define PV_D0(d0) do { s16x4 l0, l1, l2, l3, h0, h1, h2, h3; constexpr int b_ = VB * SHM_V + v_rd_off(d0, 0, 0);   \
        TRRD(l0, b_); TRRD(h0, b_ + 2048); TRRD(l1, b_ + 4096); TRRD(h1, b_ + 6144); TRRD(l2, b_ + 8192); TRRD(h2, b_ + 10240); TRRD(l3, b_ + 12288); TRRD(h3, b_ + 14336); \
        asm volatile("s_waitcnt lgkmcnt(0)" ::: "memory"); SBAR();   \
        o[d0] = __builtin_amdgcn_mfma_f32_32x32x16_bf16(pa0, (bf16x8){l0[0], l0[1], l0[2], l0[3], h0[0], h0[1], h0[2], h0[3]}, o[d0], 0, 0, 0);   \
        o[d0] = __builtin_amdgcn_mfma_f32_32x32x16_bf16(pa1, (bf16x8){l1[0], l1[1], l1[2], l1[3], h1[0], h1[1], h1[2], h1[3]}, o[d0], 0, 0, 0);   \
        o[d0] = __builtin_amdgcn_mfma_f32_32x32x16_bf16(pa2, (bf16x8){l2[0], l2[1], l2[2], l2[3], h2[0], h2[1], h2[2], h2[3]}, o[d0], 0, 0, 0);   \
        o[d0] = __builtin_amdgcn_mfma_f32_32x32x16_bf16(pa3, (bf16x8){l3[0], l3[1], l3[2], l3[3], h3[0], h3[1], h3[2], h3[3]}, o[d0], 0, 0, 0); } while (0)
    PV_D0(0); PV_D0(1); PV_D0(2); PV_D0(3);
#undef PV_D0
#undef TRRD
}
struct BlockRef { const bf16* Q; const bf16* K; const bf16* V; const float* bias; bf16* O; float* ML; int P0, W, dmask, ldo, flags; };
struct Seam { bf16x8 qr[8]; v2u st_v0, st_v1, st_k0, st_k1; float st_b; };
struct State { float m_reg, l_reg; f32x16 o[4]; };
__device__ __forceinline__ int swa_jlo(int P0, int W) { const int lowk = P0 - W + 1; return lowk > 0 ? lowk / KVBLK : 0; }
#define ROW(p, k0, rr) ((p) + (size_t)((k0) + (rr)) * D + sc)
#define VMW() asm volatile("s_waitcnt vmcnt(0)" ::: "memory")
#define VMWN(n) asm volatile("s_waitcnt vmcnt(%0)" :: "i"(n) : "memory")
#define ROW8(p, k0, rr) ((const unsigned char*)(p) + (size_t)(((k0) + (rr)) * D) + lo8)
#define WIDE8(w_) __builtin_bit_cast(bf16x8, (v4u){__builtin_bit_cast(unsigned, __builtin_amdgcn_cvt_scalef32_pk_bf16_fp8((w_).x, 1.0f, false)), __builtin_bit_cast(unsigned, __builtin_amdgcn_cvt_scalef32_pk_bf16_fp8((w_).x, 1.0f, true)), \
                                                    __builtin_bit_cast(unsigned, __builtin_amdgcn_cvt_scalef32_pk_bf16_fp8((w_).y, 1.0f, false)), __builtin_bit_cast(unsigned, __builtin_amdgcn_cvt_scalef32_pk_bf16_fp8((w_).y, 1.0f, true))})
#define SLOAD_H(Kp, Vp, Bp, k0) do { S.st_v0 = *(const v2u*)ROW8(Vp, k0, 0); S.st_v1 = *(const v2u*)ROW8(Vp, k0, 32);              \
                         S.st_k0 = *(const v2u*)ROW8(Kp, k0, 0); S.st_k1 = *(const v2u*)ROW8(Kp, k0, 32); S.st_b = *(const float*)((const char*)(Bp) + (size_t)((k0) * 4) + bo4); } while (0)
#define SWRITE_HK(bf) do { asm volatile("" : "+v"(S.st_k0), "+v"(S.st_k1)); *(bf16x8*)(K_lds + (bf) * SHM_K + kws) = WIDE8(S.st_k0); *(bf16x8*)(K_lds + (bf) * SHM_K + kws + 32 * 256) = WIDE8(S.st_k1); \
                           if (tid < 64) *(float*)(B_lds + (bf) * (KVBLK * 4) + tid * 4) = S.st_b; } while (0)
#define SWRITE_HV(bf) do { asm volatile("" : "+v"(S.st_v0), "+v"(S.st_v1)); *(bf16x8*)(V_lds + (bf) * SHM_V + vst0) = WIDE8(S.st_v0); *(bf16x8*)(V_lds + (bf) * SHM_V + vst1) = WIDE8(S.st_v1); } while (0)
#define SWRITE_H(bf) do { SWRITE_HV(bf); SWRITE_HK(bf); } while (0)
__device__ __forceinline__ void swa_prime(const BlockRef& cur, char* lds, Seam& S, const int tid) {
    const int wid = __builtin_amdgcn_readfirstlane(tid >> 6), lane = tid & 63, r32 = lane & 31, hi = lane >> 5;
    const int sr = tid >> 4, sc = (tid & 15) * 8, kws = KSWZ(sr, sc * 2); char* K_lds = lds + 2 * SHM_V; char* B_lds = lds + OFF_BIAS;
    const unsigned lo8 = (unsigned)(sr * D + sc), bo4 = (unsigned)((tid & 63) * 4);
    const int kb0 = swa_jlo(cur.P0, cur.W) * KVBLK;
    for (int d0 = 0; d0 < 8; ++d0) S.qr[d0] = *(const bf16x8*)((const char*)cur.Q + (size_t)(wid * QBLK * D * 2 + d0 * 32) + (unsigned)((r32 * D + hi * 8) * 2));
    SLOAD_H(cur.K, cur.V, cur.bias, kb0); VMW(); SWRITE_HK(0);
    __syncthreads();
}
__device__ __forceinline__ void swa_block(const BlockRef& cur, const BlockRef& nxt, char* lds, Seam& S, State& st, const int tid) {
    const int wid = __builtin_amdgcn_readfirstlane(tid >> 6), lane = tid & 63, r32 = lane & 31, hi = lane >> 5;
    const int W = cur.W, dmask = cur.dmask;
    const int j_lo = swa_jlo(cur.P0, W);
    const int j_hi = (cur.P0 + QB - 1) / KVBLK + 1;
    const int NT = j_hi - j_lo;
    const int kbn = swa_jlo(nxt.P0, nxt.W) * KVBLK;
    const int qlo = cur.P0 + wid * QBLK, qm = qlo + r32 - 4 * hi;
    const bool cls = (cur.flags & 4) != 0; const unsigned Wl = (unsigned)((qlo + r32) & 127) + 1u;
    char* V_lds = lds; char* K_lds = lds + 2 * SHM_V; char* B_lds = lds + OFF_BIAS;
    float* ws = (float*)(lds + OFF_WS) + wid * 64; float* li_l = ws, * al_l = ws + 32;
    if (cur.flags & 1) { st.m_reg = -1e30f; st.l_reg = 0.f;
#pragma unroll
        for (int d_ = 0; d_ < 4; ++d_)
#pragma unroll
            for (int r = 0; r < 16; ++r) st.o[d_][r] = 0.f; }
    float& m_reg = st.m_reg; float& l_reg = st.l_reg; f32x16* o = st.o;
    const int sr = tid >> 4, sc = (tid & 15) * 8, vst0 = v_st(sr, sc), vst1 = v_st(32 + sr, sc), kws = KSWZ(sr, sc * 2);
    const unsigned lo8 = (unsigned)(sr * D + sc), bo4 = (unsigned)((tid & 63) * 4);
    const int vb0 = (int)(uintptr_t)V_lds + v_rd_base(lane);
    const bf16* Kh = cur.K; const bf16* Vh = cur.V; const float* Bh = cur.bias;
#define RESC(a) do { if (__any((a) < 1.f)) { if (hi == 0) al_l[r32] = (a); asm volatile("s_waitcnt lgkmcnt(0)" ::: "memory");              \
                     for (int d_ = 0; d_ < 4; ++d_) for (int r = 0; r < 16; ++r) o[d_][r] *= al_l[crow(r, hi)]; } } while (0)
#define KBASE(t) ((j_lo + (t)) * KVBLK)
#define MASKT(P0_, P1_, t) do { const int kb_ = KBASE(t); if (dmask) mask_tile<true>(P0_, P1_, qm - kb_, (unsigned)W, dmask); \
        else if (cls) mask_tile<false>(P0_, P1_, qm - kb_, Wl, 0); \
        else if (kb_ + KVBLK - 1 > qlo || kb_ <= qlo + QBLK - 1 - W) mask_tile<false>(P0_, P1_, qm - kb_, (unsigned)W, 0); } while (0)
    constexpr int NQL = 8;
#define SEAM_K0() do { VMWN(NQL); SWRITE_HK(0); SBAR(); } while (0)
    f32x16 pA0, pA1, pB0, pB1; float mnA, mnB, alA, alB; bf16x8 pa0, pa1, pa2, pa3;
    SWRITE_HV(0); SBAR();
    if (NT > 1) { SLOAD_H(Kh, Vh, Bh, KBASE(1)); }
    SBAR(); qkt<0>(pA0, pA1, K_lds, B_lds, r32, hi, S.qr);
    MASKT(pA0, pA1, 0); partialSM(pA0, pA1, m_reg, mnA, alA);
    if (NT > 1) { VMW(); SWRITE_H(1); }
    RESC(alA);
    __syncthreads();
#define HALF_STEP(PX0, PX1, mnX, alX, PY0, PY1, alY, t, KB, VB, SB) do {                                                      \
        SBAR(); qkt<KB>(PX0, PX1, K_lds, B_lds, r32, hi, S.qr);                                                  \
        finishSM(PY0, PY1, alY, l_reg, pa0, pa1, pa2, pa3); SBAR();                                                           \
        if ((t) + 1 < NT) { SLOAD_H(Kh, Vh, Bh, KBASE((t) + 1)); SBAR(); }                                                      \
        pv_tile<VB>(o, vb0, pa0, pa1, pa2, pa3); MASKT(PX0, PX1, (t)); partialSM(PX0, PX1, m_reg, mnX, alX);                   \
        __syncthreads();                                                                                                      \
        if ((t) + 1 < NT) { VMW(); SWRITE_H(SB); }                                                                            \
        RESC(alX); __syncthreads(); } while (0)
    for (int t = 1; t + 1 < NT; t += 2) {
        HALF_STEP(pB0, pB1, mnB, alB, pA0, pA1, alA, t, 1, 0, 0);
        HALF_STEP(pA0, pA1, mnA, alA, pB0, pB1, alB, t + 1, 0, 1, 1);
    }
    const bool even = (NT & 1) == 0;
    if (even) { SBAR(); qkt<1>(pB0, pB1, K_lds, B_lds, r32, hi, S.qr); SBAR(); }
    SLOAD_H(nxt.K, nxt.V, nxt.bias, kbn); SBAR();
#pragma unroll
    for (int d0 = 0; d0 < 8; ++d0) S.qr[d0] = *(const bf16x8*)((const char*)nxt.Q + (size_t)(wid * QBLK * D * 2 + d0 * 32) + (unsigned)((r32 * D + hi * 8) * 2));
    SBAR();
    finishSM(pA0, pA1, alA, l_reg, pa0, pa1, pa2, pa3); SBAR();
    pv_tile<0>(o, vb0, pa0, pa1, pa2, pa3);
    if (even) { MASKT(pB0, pB1, NT - 1); partialSM(pB0, pB1, m_reg, mnB, alB); __syncthreads(); RESC(alB);
        finishSM(pB0, pB1, alB, l_reg, pa0, pa1, pa2, pa3); SBAR(); pv_tile<1>(o, vb0, pa0, pa1, pa2, pa3); }
    SBAR(); SEAM_K0();
    if (cur.flags & 2) {
        if (cur.ML != nullptr && hi == 0) { v2u ml_; ml_.x = __float_as_uint(m_reg); ml_.y = __float_as_uint(l_reg); *(v2u*)(cur.ML + (size_t)(cls ? cls_pos(qlo + r32) : wid * QBLK + r32) * 8) = ml_; }
        if (hi == 0) li_l[r32] = l_reg; asm volatile("s_waitcnt lgkmcnt(0)" ::: "memory");
        const bool f8 = (cur.flags & 8) != 0; const int es = f8 ? 0 : 1; const float osc = f8 ? (float)(1 << O_SHIFT) : 1.0f;
        float rli[16];
#pragma unroll
        for (int r = 0; r < 16; ++r) rli[r] = __builtin_amdgcn_rcpf(li_l[crow(r, hi)]) * osc;
        unsigned char* Ow = (unsigned char*)cur.O + ((cls ? (size_t)0 : (size_t)(wid * QBLK) * cur.ldo) << es);
#pragma unroll
        for (int r = 0; r < 16; ++r) { const int orow = cls ? cls_pos(qlo + crow(r, hi)) : crow(r, hi);
#pragma unroll
            for (int d0 = 0; d0 < 4; ++d0) { const float v = o[d0][r] * rli[r];
                const float vn = __shfl_xor(v, 1);
                unsigned char* p_ = Ow + (((size_t)orow * cur.ldo + d0 * 32 + r32) << es);
                if ((r32 & 1) == 0) { if (f8) *(unsigned short*)p_ = (unsigned short)__builtin_amdgcn_cvt_pk_fp8_f32(v, vn, 0, false); else *(unsigned*)p_ = cvtpk(v, vn); } } }
    }
    __syncthreads();
#undef RESC
#undef KBASE
#undef MASKT
#undef SEAM_K0
#undef HALF_STEP
}
#undef ROW
#undef VMW
#undef VMWN
#undef SLOAD_H
#undef SWRITE_HK
#undef SWRITE_HV
#undef SWRITE_H
#undef KSWZ
#undef SBAR
}

constexpr int SCHED_MAX = 3;
__device__ const unsigned short ATT_SCHED[256][SCHED_MAX] = {
{511,65535,65535},
{503,65535,65535},
{495,65535,65535},
{487,65535,65535},
{479,65535,65535},
{471,65535,65535},
{463,65535,65535},
{455,65535,65535},
{447,65535,65535},
{439,65535,65535},
{431,65535,65535},
{423,65535,65535},
{415,65535,65535},
{407,65535,65535},
{399,65535,65535},
{391,65535,65535},
{383,65535,65535},
{375,65535,65535},
{367,65535,65535},
{359,65535,65535},
{351,65535,65535},
{343,65535,65535},
{335,65535,65535},
{327,65535,65535},
{319,65535,65535},
{311,65535,65535},
{303,65535,65535},
{295,65535,65535},
{287,65535,65535},
{279,65535,65535},
{271,65535,65535},
{263,65535,65535},
{510,65535,65535},
{502,65535,65535},
{494,65535,65535},
{486,65535,65535},
{478,65535,65535},
{470,65535,65535},
{462,65535,65535},
{454,65535,65535},
{446,65535,65535},
{438,65535,65535},
{430,65535,65535},
{422,65535,65535},
{414,65535,65535},
{406,65535,65535},
{398,65535,65535},
{390,65535,65535},
{382,65535,65535},
{374,65535,65535},
{366,65535,65535},
{358,65535,65535},
{350,65535,65535},
{342,65535,65535},
{334,65535,65535},
{326,65535,65535},
{318,65535,65535},
{310,65535,65535},
{302,65535,65535},
{294,65535,65535},
{286,65535,65535},
{278,65535,65535},
{270,65535,65535},
{262,65535,65535},
{509,223,65535},
{501,222,65535},
{493,221,65535},
{485,220,65535},
{477,219,65535},
{469,218,65535},
{461,217,65535},
{453,216,65535},
{445,215,65535},
{437,214,65535},
{429,213,65535},
{421,212,65535},
{413,211,65535},
{405,210,65535},
{397,209,65535},
{389,208,65535},
{381,207,65535},
{373,206,65535},
{365,205,65535},
{357,204,65535},
{349,203,65535},
{341,202,65535},
{333,201,65535},
{325,200,65535},
{317,199,65535},
{309,198,65535},
{301,197,65535},
{293,196,65535},
{285,195,65535},
{277,194,65535},
{269,193,65535},
{261,192,65535},
{508,255,159},
{500,254,158},
{492,253,157},
{484,252,156},
{476,251,155},
{468,250,154},
{460,249,153},
{452,248,152},
{444,247,151},
{436,246,150},
{428,245,149},
{420,244,148},
{412,243,147},
{404,242,146},
{396,241,145},
{388,240,144},
{380,239,143},
{372,238,142},
{364,237,141},
{356,236,140},
{348,235,139},
{340,234,138},
{332,233,137},
{324,232,136},
{316,231,135},
{308,230,134},
{300,229,133},
{292,228,132},
{284,227,131},
{276,226,130},
{268,225,129},
{260,224,128},
{127,378,65535},
{126,370,65535},
{125,362,65535},
{124,354,65535},
{123,346,65535},
{122,338,65535},
{119,330,65535},
{118,322,65535},
{117,314,65535},
{116,306,65535},
{115,298,65535},
{114,290,65535},
{111,282,65535},
{110,274,65535},
{109,266,65535},
{108,258,65535},
{107,120,65535},
{106,112,65535},
{103,104,65535},
{102,96,65535},
{101,88,65535},
{100,80,65535},
{99,72,65535},
{98,64,65535},
{95,56,65535},
{94,48,65535},
{93,40,65535},
{92,32,65535},
{91,24,65535},
{90,16,65535},
{87,8,65535},
{86,0,65535},
{85,505,65535},
{84,497,65535},
{83,489,65535},
{82,481,65535},
{79,473,65535},
{78,465,65535},
{77,457,65535},
{76,449,65535},
{75,441,65535},
{74,433,65535},
{71,425,65535},
{70,417,65535},
{69,409,65535},
{68,401,65535},
{67,393,65535},
{66,385,65535},
{63,377,65535},
{62,369,65535},
{61,361,65535},
{60,353,65535},
{59,345,65535},
{58,337,65535},
{55,329,65535},
{54,321,65535},
{53,313,65535},
{52,305,65535},
{51,297,65535},
{50,289,65535},
{47,281,65535},
{46,273,65535},
{45,265,65535},
{44,257,65535},
{43,504,191},
{42,496,190},
{39,488,189},
{38,480,188},
{37,472,187},
{36,464,186},
{35,456,185},
{34,448,184},
{31,440,183},
{30,432,182},
{29,424,181},
{28,416,180},
{27,408,179},
{26,400,178},
{23,392,177},
{22,384,176},
{21,376,175},
{20,368,174},
{19,360,173},
{18,352,172},
{15,344,171},
{14,336,170},
{13,328,169},
{12,320,168},
{11,312,167},
{10,304,166},
{7,296,165},
{6,288,164},
{5,280,163},
{4,272,162},
{3,264,161},
{2,256,160},
{507,121,65535},
{499,113,65535},
{491,105,65535},
{483,97,65535},
{475,89,65535},
{467,81,65535},
{459,73,65535},
{451,65,65535},
{443,57,65535},
{435,49,65535},
{427,41,65535},
{419,33,65535},
{411,25,65535},
{403,17,65535},
{395,9,65535},
{387,1,65535},
{379,506,65535},
{371,498,65535},
{363,490,65535},
{355,482,65535},
{347,474,65535},
{339,466,65535},
{331,458,65535},
{323,450,65535},
{315,442,65535},
{307,434,65535},
{299,426,65535},
{291,418,65535},
{283,410,65535},
{275,402,65535},
{267,394,65535},
{259,386,65535}
};
struct AttPtrs { const bf16_t* Q; const bf16_t* K; const bf16_t* V; const float* kbias; const float* zbias; bf16_t* O01; bf16_t* O2; float* ML01; float* ML2; bf16_t* OB; };
constexpr int ATT_NITEMS = 128 + 128 + 256;
__device__ __forceinline__ att::BlockRef att_ref(const AttPtrs& P, int code, int sub) {
    att::BlockRef r;
    if (code < 256) {
        const int c2 = code & 127, b = c2 >> 5, slot = (c2 >> 3) & 3, qb = c2 & 7, g = code < 128 ? 1 - sub : 2, dil = g == 0 ? 1 : (g == 1 ? 4 : 16), head = g * 4 + slot;
        const size_t hb = ((size_t)b * NHEADS + head) * SEQ * HD;
        r.Q = P.Q + hb + (size_t)qb * 256 * HD; r.K = (const bf16_t*)((const unsigned char*)P.K + hb); r.V = (const bf16_t*)((const unsigned char*)P.V + hb); r.bias = P.zbias;
        r.ldo = A_OUT; r.P0 = qb * 256;
        if (code < 128) { r.O = P.O01 + ((size_t)b * SEQ + qb * 256) * A_OUT + slot * HD; r.ML = P.ML01 + (((size_t)b * SEQ + qb * 256) * 4 + slot) * 2;
            r.W = 128 * dil + 1; r.dmask = dil - 1; r.flags = (sub == 0 ? 1 : 0) | (sub == 1 ? 2 : 0); }
        else {
            r.O = P.O2 + ((size_t)b * SEQ) * A_OUT + slot * HD; r.ML = P.ML2 + (((size_t)b * SEQ) * 4 + slot) * 2; r.W = 1; r.dmask = 0; r.flags = 3 | 4; }
    } else {
        const int c2 = code - 256, bh = c2 >> 3, qb = c2 & 7, b = bh >> 3, h = bh & 7;
        const size_t hb = ((size_t)b * NHEADS + DIL_HEADS + h) * SEQ * HD;
        r.Q = P.Q + hb + (size_t)qb * 256 * HD; r.K = (const bf16_t*)((const unsigned char*)P.K + hb); r.V = (const bf16_t*)((const unsigned char*)P.V + hb); r.bias = P.kbias + (size_t)bh * SEQ;
        r.O = (bf16_t*)((unsigned char*)P.OB + ((size_t)b * SEQ + qb * 256) * B_OUT + h * HD); r.ldo = B_OUT; r.ML = nullptr;
        r.P0 = qb * 256; r.W = 1 << 20; r.dmask = 0; r.flags = 3 | 8;
    }
    return r;
}
__device__ __forceinline__ bool att_nth(const AttPtrs& P, int w, int G, int n, att::BlockRef& r) {
    for (int k = 0;; ++k) {
        int code;
        if (G == 256) { if (k >= SCHED_MAX) return false; code = ATT_SCHED[w][k]; if (code == 0xFFFF) return false; }
        else { code = w + k * G; if (code >= ATT_NITEMS) return false; }
        const int ns = code < 128 ? 2 : 1;
        if (n < ns) { r = att_ref(P, code, n); return true; }
        n -= ns;
    }
}
__device__ __forceinline__ void phase_attn(const AttPtrs& P, char* lds, const int tid) {
    const int w = blockIdx.x, G = gridDim.x;
    att::BlockRef cur, nxt;
    if (!att_nth(P, w, G, 0, cur)) return;
    att::Seam S; att::State st;
    att::swa_prime(cur, lds, S, tid);
    for (int n = 0;; ++n) {
        const bool more = att_nth(P, w, G, n + 1, nxt);
        if (!more) nxt = cur;
        att::swa_block(cur, nxt, lds, S, st, tid);
        if (!more) break;
        cur = nxt;
    }
}

__device__ __forceinline__ void phase_attn_combine(const bf16_t* O01, const bf16_t* O2, const float* ML01, const float* ML2, unsigned char* OA8, const bf16_t* OB, unsigned char* OB8, const Ctx& c) {
    constexpr float OS = (float)(1 << O_SHIFT);
    for (int i = blockIdx.x * NTHREADS + c.tid; i < T * 4 * 16; i += gridDim.x * NTHREADS) {
        const int rs = i >> 4, ch = i & 15;
        const v2u a = *(const v2u*)(ML01 + (size_t)rs * 2), b = *(const v2u*)(ML2 + (size_t)rs * 2);
        const float m1 = __uint_as_float(a.x), l1 = __uint_as_float(a.y), m2 = __uint_as_float(b.x), l2 = __uint_as_float(b.y), M = fmaxf(m1, m2);
        float w1 = l1 * exp2f(m1 - M), w2 = l2 * exp2f(m2 - M); const float inv = 1.0f / (w1 + w2); w1 *= inv; w2 *= inv;
        const size_t o = (size_t)rs * HD + ch * 8;
        const v4u x = *(const v4u*)(O01 + o), y = *(const v4u*)(O2 + o);
        w1 *= OS; w2 *= OS;
        int p0 = __builtin_amdgcn_cvt_pk_fp8_f32(w1 * bflo(x.x) + w2 * bflo(y.x), w1 * bfhi(x.x) + w2 * bfhi(y.x), 0, false); p0 = __builtin_amdgcn_cvt_pk_fp8_f32(w1 * bflo(x.y) + w2 * bflo(y.y), w1 * bfhi(x.y) + w2 * bfhi(y.y), p0, true);
        int p1 = __builtin_amdgcn_cvt_pk_fp8_f32(w1 * bflo(x.z) + w2 * bflo(y.z), w1 * bfhi(x.z) + w2 * bfhi(y.z), 0, false); p1 = __builtin_amdgcn_cvt_pk_fp8_f32(w1 * bflo(x.w) + w2 * bflo(y.w), w1 * bfhi(x.w) + w2 * bfhi(y.w), p1, true);
        *(v2u*)(OA8 + o) = (v2u){(unsigned)p0, (unsigned)p1};
    }
}
__device__ __forceinline__ float gelu_exact(float x) { return 0.5f * x * (1.0f + erff(x * 0.70710678118654752f)); }
__device__ __forceinline__ void phase_peer_naive(const bf16_t* xn, const bf16_t* query, const bf16_t* sk_l, const bf16_t* eu_l, const bf16_t* ev_l, const float* x1, float* xout, const Ctx& c) {
    for (int t = c.gw; t < T; t += c.ngw) {
        v4u xr[4];
#pragma unroll
        for (int j = 0; j < 4; ++j) xr[j] = ((const v4u*)(xn + (size_t)t * DM))[c.lane + 64 * j];
        float acc[32];
#pragma unroll
        for (int i = 0; i < 32; ++i) acc[i] = 0.f;
#pragma unroll 1
        for (int h = 0; h < PEER_HEADS; ++h) {
            unsigned top[2];
#pragma unroll
            for (int hc = 0; hc < 2; ++hc) {
                const v4u* qp = (const v4u*)(query + (size_t)t * DM + h * 256 + hc * 128);
                const v4u* k0p = (const v4u*)(sk_l + (((size_t)h * 2 + hc) * NKEYS + c.lane) * HD);
                const v4u* k1p = (const v4u*)(sk_l + (((size_t)h * 2 + hc) * NKEYS + c.lane + 64) * HD);
                float s0 = 0.f, s1 = 0.f;
#pragma unroll 4
                for (int k = 0; k < 16; ++k) { const v4u q = qp[k], a = k0p[k], b = k1p[k];
                    s0 = dot2(q.x, a.x, s0); s0 = dot2(q.y, a.y, s0); s0 = dot2(q.z, a.z, s0); s0 = dot2(q.w, a.w, s0);
                    s1 = dot2(q.x, b.x, s1); s1 = dot2(q.y, b.y, s1); s1 = dot2(q.z, b.z, s1); s1 = dot2(q.w, b.w, s1); }
                unsigned p0 = (ord_f(s0) & ~127u) | (unsigned)c.lane, p1 = (ord_f(s1) & ~127u) | (unsigned)(c.lane + 64);
                unsigned mine = 0u;
#pragma unroll 1
                for (int i = 0; i < TOPK; ++i) {
                    const unsigned mx = wave_max_u(p0 > p1 ? p0 : p1);
                    if (p0 == mx) p0 = 0u; if (p1 == mx) p1 = 0u;
                    if (c.lane == i) mine = mx;
                }
                top[hc] = mine;
            }
            const float v0 = unord_f((unsigned)__shfl((int)top[0], c.lane & 15) & ~127u);
            unsigned cand[4];
#pragma unroll
            for (int r = 0; r < 4; ++r) { const int j = (c.lane >> 4) + 4 * r; const float v1 = unord_f((unsigned)__shfl((int)top[1], j) & ~127u);
                cand[r] = (ord_f(v0 + v1) & ~255u) | (unsigned)((c.lane & 15) * 16 + j); }
            unsigned best = 0u;
#pragma unroll 1
            for (int i = 0; i < TOPK; ++i) {
                unsigned mloc = cand[0] > cand[1] ? cand[0] : cand[1]; const unsigned m2 = cand[2] > cand[3] ? cand[2] : cand[3]; mloc = mloc > m2 ? mloc : m2;
                const unsigned mx = wave_max_u(mloc);
#pragma unroll
                for (int r = 0; r < 4; ++r) if (cand[r] == mx) cand[r] = 0u;
                if (c.lane == i) best = mx;
            }
            const int bi = (int)((best >> 4) & 15u), bj = (int)(best & 15u);
            const unsigned i0 = (unsigned)__shfl((int)top[0], bi) & 127u, i1 = (unsigned)__shfl((int)top[1], bj) & 127u;
            const int expert = (int)(i0 * NKEYS + i1);
            const float bs = unord_f(best & ~255u);
            const float bmax = __shfl(bs, 0);
            const float e = c.lane < TOPK ? expf(bs - bmax) : 0.f;
            const float gate = e / wave_sum(e);
#pragma unroll 1
            for (int r = 0; r < TOPK; ++r) {
                const int ex = __shfl(expert, r); const float g = __shfl(gate, r);
                const v4u* up = (const v4u*)(eu_l + (size_t)ex * DM); const v4u* vp = (const v4u*)(ev_l + (size_t)ex * DM);
                float d = 0.f;
#pragma unroll
                for (int j = 0; j < 4; ++j) { const v4u u = up[c.lane + 64 * j]; d = dot2(u.x, xr[j].x, d); d = dot2(u.y, xr[j].y, d); d = dot2(u.z, xr[j].z, d); d = dot2(u.w, xr[j].w, d); }
                d = wave_sum(d);
                const float w = g * gelu_exact(d);
#pragma unroll
                for (int j = 0; j < 4; ++j) { const v4u vv = vp[c.lane + 64 * j];
                    acc[8 * j + 0] += w * bflo(vv.x); acc[8 * j + 1] += w * bfhi(vv.x); acc[8 * j + 2] += w * bflo(vv.y); acc[8 * j + 3] += w * bfhi(vv.y);
                    acc[8 * j + 4] += w * bflo(vv.z); acc[8 * j + 5] += w * bfhi(vv.z); acc[8 * j + 6] += w * bflo(vv.w); acc[8 * j + 7] += w * bfhi(vv.w); }
            }
        }
#pragma unroll
        for (int j = 0; j < 4; ++j) {
            const size_t o = (size_t)t * DM + 8 * (c.lane + 64 * j);
            const f32x4 a = *(const f32x4*)(x1 + o), b = *(const f32x4*)(x1 + o + 4);
            f32x4 ra, rb; ra.x = a.x + acc[8 * j + 0]; ra.y = a.y + acc[8 * j + 1]; ra.z = a.z + acc[8 * j + 2]; ra.w = a.w + acc[8 * j + 3];
            rb.x = b.x + acc[8 * j + 4]; rb.y = b.y + acc[8 * j + 5]; rb.z = b.z + acc[8 * j + 6]; rb.w = b.w + acc[8 * j + 7];
            *(f32x4*)(xout + o) = ra; *(f32x4*)(xout + o + 4) = rb;
        }
    }
}

namespace peer {
constexpr int CH = 32, L_LIST = 0, L_TAB = 32768, L_STAB = 65536, L_ML2 = 98304, LDS_BYTES_PEER = 131072;
typedef short bf16x8 __attribute__((ext_vector_type(8)));
typedef float f32x16 __attribute__((ext_vector_type(16)));
__device__ __forceinline__ unsigned umax(unsigned a, unsigned b) { return a > b ? a : b; }
__device__ __forceinline__ unsigned umin(unsigned a, unsigned b) { return a < b ? a : b; }
__device__ __forceinline__ unsigned pair_max(unsigned m) { auto rr = __builtin_amdgcn_permlane32_swap(m, m, false, false); return umax(rr[0], rr[1]); }
struct Stair { int i[50], j[50]; };
constexpr Stair make_stair() { Stair s{}; int n = 0; for (int i = 0; i < 16; ++i) for (int j = 0; j < 16; ++j) if ((i + 1) * (j + 1) <= 16) { s.i[n] = i; s.j[n] = j; ++n; } return s; }
constexpr Stair STAIR = make_stair();
constexpr int lane_of(int e) { return (((e >> 3) & 1) << 5) | (((e >> 2) & 1) << 4) | (((e >> 1) & 1) << 3) | ((e & 1) << 2); }
__device__ __forceinline__ int slot_of(int lane) { return (((lane >> 5) & 1) << 3) | (((lane >> 4) & 1) << 2) | (((lane >> 3) & 1) << 1) | ((lane >> 2) & 1); }

#define PEER_CE(a_, b_) do { const unsigned t_ = umax(v[a_], v[b_]); v[b_] = umin(v[a_], v[b_]); v[a_] = t_; } while (0)
__device__ __forceinline__ void top16_pair(unsigned (&v)[64], int hi) {
    PEER_CE(0, 1); PEER_CE(2, 3); PEER_CE(0, 2); PEER_CE(1, 3); PEER_CE(1, 2); PEER_CE(4, 5); PEER_CE(6, 7); PEER_CE(4, 6); PEER_CE(5, 7); PEER_CE(5, 6); PEER_CE(0, 4); PEER_CE(2, 6); PEER_CE(2, 4); PEER_CE(1, 5); PEER_CE(3, 7); PEER_CE(3, 5); PEER_CE(1, 2); PEER_CE(3, 4); PEER_CE(5, 6); PEER_CE(8, 9); PEER_CE(10, 11); PEER_CE(8, 10); PEER_CE(9, 11); PEER_CE(9, 10); PEER_CE(12, 13); PEER_CE(14, 15); PEER_CE(12, 14); PEER_CE(13, 15); PEER_CE(13, 14); PEER_CE(8, 12); PEER_CE(10, 14); PEER_CE(10, 12); PEER_CE(9, 13); PEER_CE(11, 15); PEER_CE(11, 13); PEER_CE(9, 10); PEER_CE(11, 12); PEER_CE(13, 14); PEER_CE(0, 8); PEER_CE(4, 12); PEER_CE(4, 8); PEER_CE(2, 10); PEER_CE(6, 14); PEER_CE(6, 10); PEER_CE(2, 4); PEER_CE(6, 8); PEER_CE(10, 12); PEER_CE(1, 9); PEER_CE(5, 13); PEER_CE(5, 9); PEER_CE(3, 11); PEER_CE(7, 15); PEER_CE(7, 11); PEER_CE(3, 5); PEER_CE(7, 9); PEER_CE(11, 13); PEER_CE(1, 2); PEER_CE(3, 4); PEER_CE(5, 6); PEER_CE(7, 8); PEER_CE(9, 10); PEER_CE(11, 12); PEER_CE(13, 14);
    PEER_CE(16, 17); PEER_CE(18, 19); PEER_CE(16, 18); PEER_CE(17, 19); PEER_CE(17, 18); PEER_CE(20, 21); PEER_CE(22, 23); PEER_CE(20, 22); PEER_CE(21, 23); PEER_CE(21, 22); PEER_CE(16, 20); PEER_CE(18, 22); PEER_CE(18, 20); PEER_CE(17, 21); PEER_CE(19, 23); PEER_CE(19, 21); PEER_CE(17, 18); PEER_CE(19, 20); PEER_CE(21, 22); PEER_CE(24, 25); PEER_CE(26, 27); PEER_CE(24, 26); PEER_CE(25, 27); PEER_CE(25, 26); PEER_CE(28, 29); PEER_CE(30, 31); PEER_CE(28, 30); PEER_CE(29, 31); PEER_CE(29, 30); PEER_CE(24, 28); PEER_CE(26, 30); PEER_CE(26, 28); PEER_CE(25, 29); PEER_CE(27, 31); PEER_CE(27, 29); PEER_CE(25, 26); PEER_CE(27, 28); PEER_CE(29, 30); PEER_CE(16, 24); PEER_CE(20, 28); PEER_CE(20, 24); PEER_CE(18, 26); PEER_CE(22, 30); PEER_CE(22, 26); PEER_CE(18, 20); PEER_CE(22, 24); PEER_CE(26, 28); PEER_CE(17, 25); PEER_CE(21, 29); PEER_CE(21, 25); PEER_CE(19, 27); PEER_CE(23, 31); PEER_CE(23, 27); PEER_CE(19, 21); PEER_CE(23, 25); PEER_CE(27, 29); PEER_CE(17, 18); PEER_CE(19, 20); PEER_CE(21, 22); PEER_CE(23, 24); PEER_CE(25, 26); PEER_CE(27, 28); PEER_CE(29, 30);
    PEER_CE(32, 33); PEER_CE(34, 35); PEER_CE(32, 34); PEER_CE(33, 35); PEER_CE(33, 34); PEER_CE(36, 37); PEER_CE(38, 39); PEER_CE(36, 38); PEER_CE(37, 39); PEER_CE(37, 38); PEER_CE(32, 36); PEER_CE(34, 38); PEER_CE(34, 36); PEER_CE(33, 37); PEER_CE(35, 39); PEER_CE(35, 37); PEER_CE(33, 34); PEER_CE(35, 36); PEER_CE(37, 38); PEER_CE(40, 41); PEER_CE(42, 43); PEER_CE(40, 42); PEER_CE(41, 43); PEER_CE(41, 42); PEER_CE(44, 45); PEER_CE(46, 47); PEER_CE(44, 46); PEER_CE(45, 47); PEER_CE(45, 46); PEER_CE(40, 44); PEER_CE(42, 46); PEER_CE(42, 44); PEER_CE(41, 45); PEER_CE(43, 47); PEER_CE(43, 45); PEER_CE(41, 42); PEER_CE(43, 44); PEER_CE(45, 46); PEER_CE(32, 40); PEER_CE(36, 44); PEER_CE(36, 40); PEER_CE(34, 42); PEER_CE(38, 46); PEER_CE(38, 42); PEER_CE(34, 36); PEER_CE(38, 40); PEER_CE(42, 44); PEER_CE(33, 41); PEER_CE(37, 45); PEER_CE(37, 41); PEER_CE(35, 43); PEER_CE(39, 47); PEER_CE(39, 43); PEER_CE(35, 37); PEER_CE(39, 41); PEER_CE(43, 45); PEER_CE(33, 34); PEER_CE(35, 36); PEER_CE(37, 38); PEER_CE(39, 40); PEER_CE(41, 42); PEER_CE(43, 44); PEER_CE(45, 46);
    PEER_CE(48, 49); PEER_CE(50, 51); PEER_CE(48, 50); PEER_CE(49, 51); PEER_CE(49, 50); PEER_CE(52, 53); PEER_CE(54, 55); PEER_CE(52, 54); PEER_CE(53, 55); PEER_CE(53, 54); PEER_CE(48, 52); PEER_CE(50, 54); PEER_CE(50, 52); PEER_CE(49, 53); PEER_CE(51, 55); PEER_CE(51, 53); PEER_CE(49, 50); PEER_CE(51, 52); PEER_CE(53, 54); PEER_CE(56, 57); PEER_CE(58, 59); PEER_CE(56, 58); PEER_CE(57, 59); PEER_CE(57, 58); PEER_CE(60, 61); PEER_CE(62, 63); PEER_CE(60, 62); PEER_CE(61, 63); PEER_CE(61, 62); PEER_CE(56, 60); PEER_CE(58, 62); PEER_CE(58, 60); PEER_CE(57, 61); PEER_CE(59, 63); PEER_CE(59, 61); PEER_CE(57, 58); PEER_CE(59, 60); PEER_CE(61, 62); PEER_CE(48, 56); PEER_CE(52, 60); PEER_CE(52, 56); PEER_CE(50, 58); PEER_CE(54, 62); PEER_CE(54, 58); PEER_CE(50, 52); PEER_CE(54, 56); PEER_CE(58, 60); PEER_CE(49, 57); PEER_CE(53, 61); PEER_CE(53, 57); PEER_CE(51, 59); PEER_CE(55, 63); PEER_CE(55, 59); PEER_CE(51, 53); PEER_CE(55, 57); PEER_CE(59, 61); PEER_CE(49, 50); PEER_CE(51, 52); PEER_CE(53, 54); PEER_CE(55, 56); PEER_CE(57, 58); PEER_CE(59, 60); PEER_CE(61, 62);
    v[0] = umax(v[0], v[31]); v[1] = umax(v[1], v[30]); v[2] = umax(v[2], v[29]); v[3] = umax(v[3], v[28]); v[4] = umax(v[4], v[27]); v[5] = umax(v[5], v[26]); v[6] = umax(v[6], v[25]); v[7] = umax(v[7], v[24]); v[8] = umax(v[8], v[23]); v[9] = umax(v[9], v[22]); v[10] = umax(v[10], v[21]); v[11] = umax(v[11], v[20]); v[12] = umax(v[12], v[19]); v[13] = umax(v[13], v[18]); v[14] = umax(v[14], v[17]); v[15] = umax(v[15], v[16]);
    PEER_CE(0, 8); PEER_CE(1, 9); PEER_CE(2, 10); PEER_CE(3, 11); PEER_CE(4, 12); PEER_CE(5, 13); PEER_CE(6, 14); PEER_CE(7, 15); PEER_CE(0, 4); PEER_CE(1, 5); PEER_CE(2, 6); PEER_CE(3, 7); PEER_CE(0, 2); PEER_CE(1, 3); PEER_CE(0, 1); PEER_CE(2, 3); PEER_CE(4, 6); PEER_CE(5, 7); PEER_CE(4, 5); PEER_CE(6, 7); PEER_CE(8, 12); PEER_CE(9, 13); PEER_CE(10, 14); PEER_CE(11, 15); PEER_CE(8, 10); PEER_CE(9, 11); PEER_CE(8, 9); PEER_CE(10, 11); PEER_CE(12, 14); PEER_CE(13, 15); PEER_CE(12, 13); PEER_CE(14, 15);
    v[32] = umax(v[32], v[63]); v[33] = umax(v[33], v[62]); v[34] = umax(v[34], v[61]); v[35] = umax(v[35], v[60]); v[36] = umax(v[36], v[59]); v[37] = umax(v[37], v[58]); v[38] = umax(v[38], v[57]); v[39] = umax(v[39], v[56]); v[40] = umax(v[40], v[55]); v[41] = umax(v[41], v[54]); v[42] = umax(v[42], v[53]); v[43] = umax(v[43], v[52]); v[44] = umax(v[44], v[51]); v[45] = umax(v[45], v[50]); v[46] = umax(v[46], v[49]); v[47] = umax(v[47], v[48]);
    PEER_CE(32, 40); PEER_CE(33, 41); PEER_CE(34, 42); PEER_CE(35, 43); PEER_CE(36, 44); PEER_CE(37, 45); PEER_CE(38, 46); PEER_CE(39, 47); PEER_CE(32, 36); PEER_CE(33, 37); PEER_CE(34, 38); PEER_CE(35, 39); PEER_CE(32, 34); PEER_CE(33, 35); PEER_CE(32, 33); PEER_CE(34, 35); PEER_CE(36, 38); PEER_CE(37, 39); PEER_CE(36, 37); PEER_CE(38, 39); PEER_CE(40, 44); PEER_CE(41, 45); PEER_CE(42, 46); PEER_CE(43, 47); PEER_CE(40, 42); PEER_CE(41, 43); PEER_CE(40, 41); PEER_CE(42, 43); PEER_CE(44, 46); PEER_CE(45, 47); PEER_CE(44, 45); PEER_CE(46, 47);
    v[0] = umax(v[0], v[47]); v[1] = umax(v[1], v[46]); v[2] = umax(v[2], v[45]); v[3] = umax(v[3], v[44]); v[4] = umax(v[4], v[43]); v[5] = umax(v[5], v[42]); v[6] = umax(v[6], v[41]); v[7] = umax(v[7], v[40]); v[8] = umax(v[8], v[39]); v[9] = umax(v[9], v[38]); v[10] = umax(v[10], v[37]); v[11] = umax(v[11], v[36]); v[12] = umax(v[12], v[35]); v[13] = umax(v[13], v[34]); v[14] = umax(v[14], v[33]); v[15] = umax(v[15], v[32]);
    PEER_CE(0, 8); PEER_CE(1, 9); PEER_CE(2, 10); PEER_CE(3, 11); PEER_CE(4, 12); PEER_CE(5, 13); PEER_CE(6, 14); PEER_CE(7, 15); PEER_CE(0, 4); PEER_CE(1, 5); PEER_CE(2, 6); PEER_CE(3, 7); PEER_CE(0, 2); PEER_CE(1, 3); PEER_CE(0, 1); PEER_CE(2, 3); PEER_CE(4, 6); PEER_CE(5, 7); PEER_CE(4, 5); PEER_CE(6, 7); PEER_CE(8, 12); PEER_CE(9, 13); PEER_CE(10, 14); PEER_CE(11, 15); PEER_CE(8, 10); PEER_CE(9, 11); PEER_CE(8, 9); PEER_CE(10, 11); PEER_CE(12, 14); PEER_CE(13, 15); PEER_CE(12, 13); PEER_CE(14, 15);
    unsigned pv[16];
#pragma unroll
    for (int i = 0; i < 16; ++i) { auto rr = __builtin_amdgcn_permlane32_swap(v[15 - i], v[15 - i], false, false); pv[i] = hi ? rr[0] : rr[1]; }
#pragma unroll
    for (int i = 0; i < 16; ++i) v[i] = umax(v[i], pv[i]);
    PEER_CE(0, 8); PEER_CE(1, 9); PEER_CE(2, 10); PEER_CE(3, 11); PEER_CE(4, 12); PEER_CE(5, 13); PEER_CE(6, 14); PEER_CE(7, 15); PEER_CE(0, 4); PEER_CE(1, 5); PEER_CE(2, 6); PEER_CE(3, 7); PEER_CE(0, 2); PEER_CE(1, 3); PEER_CE(0, 1); PEER_CE(2, 3); PEER_CE(4, 6); PEER_CE(5, 7); PEER_CE(4, 5); PEER_CE(6, 7); PEER_CE(8, 12); PEER_CE(9, 13); PEER_CE(10, 14); PEER_CE(11, 15); PEER_CE(8, 10); PEER_CE(9, 11); PEER_CE(8, 9); PEER_CE(10, 11); PEER_CE(12, 14); PEER_CE(13, 15); PEER_CE(12, 13); PEER_CE(14, 15);
}
__device__ __forceinline__ void top16_pair32(unsigned (&v)[32], int hi) {
    PEER_CE(0, 1); PEER_CE(2, 3); PEER_CE(0, 2); PEER_CE(1, 3); PEER_CE(1, 2); PEER_CE(4, 5); PEER_CE(6, 7); PEER_CE(4, 6); PEER_CE(5, 7); PEER_CE(5, 6); PEER_CE(0, 4); PEER_CE(2, 6); PEER_CE(2, 4); PEER_CE(1, 5); PEER_CE(3, 7); PEER_CE(3, 5); PEER_CE(1, 2); PEER_CE(3, 4); PEER_CE(5, 6); PEER_CE(8, 9); PEER_CE(10, 11); PEER_CE(8, 10); PEER_CE(9, 11); PEER_CE(9, 10); PEER_CE(12, 13); PEER_CE(14, 15); PEER_CE(12, 14); PEER_CE(13, 15); PEER_CE(13, 14); PEER_CE(8, 12); PEER_CE(10, 14); PEER_CE(10, 12); PEER_CE(9, 13); PEER_CE(11, 15); PEER_CE(11, 13); PEER_CE(9, 10); PEER_CE(11, 12); PEER_CE(13, 14); PEER_CE(0, 8); PEER_CE(4, 12); PEER_CE(4, 8); PEER_CE(2, 10); PEER_CE(6, 14); PEER_CE(6, 10); PEER_CE(2, 4); PEER_CE(6, 8); PEER_CE(10, 12); PEER_CE(1, 9); PEER_CE(5, 13); PEER_CE(5, 9); PEER_CE(3, 11); PEER_CE(7, 15); PEER_CE(7, 11); PEER_CE(3, 5); PEER_CE(7, 9); PEER_CE(11, 13); PEER_CE(1, 2); PEER_CE(3, 4); PEER_CE(5, 6); PEER_CE(7, 8); PEER_CE(9, 10); PEER_CE(11, 12); PEER_CE(13, 14);
    PEER_CE(16, 17); PEER_CE(18, 19); PEER_CE(16, 18); PEER_CE(17, 19); PEER_CE(17, 18); PEER_CE(20, 21); PEER_CE(22, 23); PEER_CE(20, 22); PEER_CE(21, 23); PEER_CE(21, 22); PEER_CE(16, 20); PEER_CE(18, 22); PEER_CE(18, 20); PEER_CE(17, 21); PEER_CE(19, 23); PEER_CE(19, 21); PEER_CE(17, 18); PEER_CE(19, 20); PEER_CE(21, 22); PEER_CE(24, 25); PEER_CE(26, 27); PEER_CE(24, 26); PEER_CE(25, 27); PEER_CE(25, 26); PEER_CE(28, 29); PEER_CE(30, 31); PEER_CE(28, 30); PEER_CE(29, 31); PEER_CE(29, 30); PEER_CE(24, 28); PEER_CE(26, 30); PEER_CE(26, 28); PEER_CE(25, 29); PEER_CE(27, 31); PEER_CE(27, 29); PEER_CE(25, 26); PEER_CE(27, 28); PEER_CE(29, 30); PEER_CE(16, 24); PEER_CE(20, 28); PEER_CE(20, 24); PEER_CE(18, 26); PEER_CE(22, 30); PEER_CE(22, 26); PEER_CE(18, 20); PEER_CE(22, 24); PEER_CE(26, 28); PEER_CE(17, 25); PEER_CE(21, 29); PEER_CE(21, 25); PEER_CE(19, 27); PEER_CE(23, 31); PEER_CE(23, 27); PEER_CE(19, 21); PEER_CE(23, 25); PEER_CE(27, 29); PEER_CE(17, 18); PEER_CE(19, 20); PEER_CE(21, 22); PEER_CE(23, 24); PEER_CE(25, 26); PEER_CE(27, 28); PEER_CE(29, 30);
    v[0] = umax(v[0], v[31]); v[1] = umax(v[1], v[30]); v[2] = umax(v[2], v[29]); v[3] = umax(v[3], v[28]); v[4] = umax(v[4], v[27]); v[5] = umax(v[5], v[26]); v[6] = umax(v[6], v[25]); v[7] = umax(v[7], v[24]); v[8] = umax(v[8], v[23]); v[9] = umax(v[9], v[22]); v[10] = umax(v[10], v[21]); v[11] = umax(v[11], v[20]); v[12] = umax(v[12], v[19]); v[13] = umax(v[13], v[18]); v[14] = umax(v[14], v[17]); v[15] = umax(v[15], v[16]);
    PEER_CE(0, 8); PEER_CE(1, 9); PEER_CE(2, 10); PEER_CE(3, 11); PEER_CE(4, 12); PEER_CE(5, 13); PEER_CE(6, 14); PEER_CE(7, 15); PEER_CE(0, 4); PEER_CE(1, 5); PEER_CE(2, 6); PEER_CE(3, 7); PEER_CE(0, 2); PEER_CE(1, 3); PEER_CE(0, 1); PEER_CE(2, 3); PEER_CE(4, 6); PEER_CE(5, 7); PEER_CE(4, 5); PEER_CE(6, 7); PEER_CE(8, 12); PEER_CE(9, 13); PEER_CE(10, 14); PEER_CE(11, 15); PEER_CE(8, 10); PEER_CE(9, 11); PEER_CE(8, 9); PEER_CE(10, 11); PEER_CE(12, 14); PEER_CE(13, 15); PEER_CE(12, 13); PEER_CE(14, 15);
    unsigned pv[16];
#pragma unroll
    for (int i = 0; i < 16; ++i) { auto rr = __builtin_amdgcn_permlane32_swap(v[15 - i], v[15 - i], false, false); pv[i] = hi ? rr[0] : rr[1]; }
#pragma unroll
    for (int i = 0; i < 16; ++i) v[i] = umax(v[i], pv[i]);
    PEER_CE(0, 8); PEER_CE(1, 9); PEER_CE(2, 10); PEER_CE(3, 11); PEER_CE(4, 12); PEER_CE(5, 13); PEER_CE(6, 14); PEER_CE(7, 15); PEER_CE(0, 4); PEER_CE(1, 5); PEER_CE(2, 6); PEER_CE(3, 7); PEER_CE(0, 2); PEER_CE(1, 3); PEER_CE(0, 1); PEER_CE(2, 3); PEER_CE(4, 6); PEER_CE(5, 7); PEER_CE(4, 5); PEER_CE(6, 7); PEER_CE(8, 12); PEER_CE(9, 13); PEER_CE(10, 14); PEER_CE(11, 15); PEER_CE(8, 10); PEER_CE(9, 11); PEER_CE(8, 9); PEER_CE(10, 11); PEER_CE(12, 14); PEER_CE(13, 15); PEER_CE(12, 13); PEER_CE(14, 15);
}
#undef PEER_CE
__device__ __forceinline__ void route(const bf16_t* query, const bf16_t* sk_l, int tok0, char* lds, int wave, int lane) {
    const int r32 = lane & 31, hi = lane >> 5, h = wave;
    unsigned* lists = (unsigned*)(lds + L_LIST) + (size_t)r32 * 256;
#pragma unroll 1
    for (int hc = 0; hc < 2; ++hc) {
        const bf16_t* sp = query + (size_t)(tok0 + r32) * DM + h * 256 + hc * 128 + hi * 64;
        unsigned v[64];
#pragma unroll
        for (int q8 = 0; q8 < 8; ++q8) { const v4u w = *(const v4u*)(sp + 8 * q8);
#pragma unroll
            for (int e2 = 0; e2 < 8; ++e2) { const int i = 8 * q8 + e2, kb = i >> 4, g4 = (i >> 2) & 3, e = i & 3; const unsigned kk = (unsigned)(kb * 32 + 8 * g4 + e) + 4u * (unsigned)hi;
                const unsigned wd = e2 < 2 ? w.x : e2 < 4 ? w.y : e2 < 6 ? w.z : w.w; v[i] = (ord_f((e2 & 1) ? bfhi(wd) : bflo(wd)) & ~127u) | kk; } }
        unsigned* lp = lists + (h * 2 + hc) * 16;
        top16_pair(v, hi);
        if (hi == 0) {
#pragma unroll
            for (int it = 0; it < TOPK; ++it) lp[it] = v[it]; }
    }
    const unsigned* la = lists + (h * 2) * 16; const unsigned* lb = la + 16;
    float av[16], bv[16];
#pragma unroll
    for (int i = 0; i < 16; ++i) { av[i] = unord_f(la[i] & ~127u); bv[i] = unord_f(lb[i] & ~127u); }
    unsigned cand[32];
#pragma unroll
    for (int n2 = 0; n2 < 25; ++n2) {
        const unsigned c0 = (ord_f(av[STAIR.i[2 * n2]] + bv[STAIR.j[2 * n2]]) & ~255u) | (unsigned)(STAIR.i[2 * n2] * 16 + STAIR.j[2 * n2]);
        const unsigned c1 = (ord_f(av[STAIR.i[2 * n2 + 1]] + bv[STAIR.j[2 * n2 + 1]]) & ~255u) | (unsigned)(STAIR.i[2 * n2 + 1] * 16 + STAIR.j[2 * n2 + 1]);
        cand[n2] = hi ? c1 : c0;
    }
#pragma unroll
    for (int n2 = 25; n2 < 32; ++n2) cand[n2] = 0u;
    top16_pair32(cand, hi);
    v2u* tab = (v2u*)(lds + L_TAB) + ((size_t)r32 * PEER_HEADS + h) * 16;
    if (hi == 0) {
#pragma unroll
        for (int it = 0; it < TOPK; ++it) { const unsigned m = cand[it]; const unsigned ia = la[(m >> 4) & 15u] & 127u, ib = lb[m & 15u] & 127u; v2u e; e.x = ia * NKEYS + ib; e.y = __float_as_uint(unord_f(m & ~255u)); tab[it] = e; }
    }
    if (hi == 0) {
        float sv[16]; float tot = 0.f;
#pragma unroll
        for (int i = 0; i < 16; ++i) sv[i] = __uint_as_float(tab[i].y);
        const float mx = sv[0];
#pragma unroll
        for (int i = 0; i < 16; ++i) { sv[i] = __expf(sv[i] - mx); tot += sv[i]; }
        const float inv = 1.0f / tot;
#pragma unroll
        for (int i = 0; i < 16; ++i) ((float*)(tab + i))[1] = sv[i] * inv;
    }
}

__device__ __forceinline__ void sort512(char* lds, int wave, int lane) {
    v2u* tabw = (v2u*)(lds + L_TAB) + (size_t)(4 * wave) * 128;
    unsigned k[8];
#pragma unroll
    for (int r = 0; r < 8; ++r) { const unsigned e = 8u * (unsigned)lane + r; k[r] = (tabw[e].x << 9) | e; }
#pragma unroll
    for (int kk = 1; kk <= 9; ++kk)
#pragma unroll
        for (int j = kk - 1; j >= 0; --j) {
            const int d = 1 << j, blk = 1 << kk;
            if (d >= 8) {
                const int dl = d >> 3; const bool lower = (lane & dl) == 0, up = kk == 9 ? true : (lane & (blk >> 3)) == 0, keepmin = lower == up;
#pragma unroll
                for (int r = 0; r < 8; ++r) { const unsigned y = (unsigned)__shfl_xor((int)k[r], dl); k[r] = keepmin ? umin(k[r], y) : umax(k[r], y); }
            } else {
#pragma unroll
                for (int r = 0; r < 8; ++r) { if (r & d) continue; const int r2 = r | d;
                    const bool up = blk >= 8 ? (kk == 9 ? true : (lane & (blk >> 3)) == 0) : (r & blk) == 0;
                    const unsigned lo = umin(k[r], k[r2]), hi = umax(k[r], k[r2]); k[r] = up ? lo : hi; k[r2] = up ? hi : lo; }
            }
        }
    unsigned g[8];
#pragma unroll
    for (int r = 0; r < 8; ++r) g[r] = tabw[k[r] & 511u].y;
    LDS_WAIT();
#pragma unroll
    for (int r = 0; r < 8; ++r) { const unsigned id = k[r] >> 9, ei = k[r] & 511u; v2u w; w.x = id | ((ei >> 7) << 14) | ((ei & 127u) << 16); w.y = g[r]; tabw[8 * lane + r] = w; }
}
__device__ __forceinline__ void sort_entries(char* lds, int wave, int lane) {
#pragma unroll 1
    for (int q = 0; q < 4; ++q) {
        const v2u* tab = (const v2u*)(lds + L_TAB) + (size_t)(4 * wave + q) * 128; v2u* st = (v2u*)(lds + L_STAB) + (size_t)(4 * wave + q) * 128;
        const v2u e0 = tab[lane], e1 = tab[lane + 64];
        const unsigned k0 = (e0.x << 7) | (unsigned)lane, k1 = (e1.x << 7) | (unsigned)(lane + 64);
        int r0 = 0, r1 = 0;
#pragma unroll 8
        for (int j = 0; j < 128; ++j) { const unsigned kj = (tab[j].x << 7) | (unsigned)j; r0 += kj < k0 ? 1 : 0; r1 += kj < k1 ? 1 : 0; }
        st[r0] = e0; st[r1] = e1;
    }
}
__device__ __forceinline__ void merge2_entries(char* lds, int wave, int lane) {
    const v2u* st = (const v2u*)(lds + L_STAB) + (size_t)(4 * wave) * 128; v2u* ml2 = (v2u*)(lds + L_ML2) + (size_t)(4 * wave) * 128;
#pragma unroll 2
    for (int tt = 0; tt < 4; ++tt)
#pragma unroll
        for (int half = 0; half < 2; ++half) {
            const int p = lane + 64 * half, o = tt ^ 1; const v2u e = st[tt * 128 + p];
            const unsigned lim = o < tt ? e.x + 1u : e.x;
            int lo = 0, hi = 128;
#pragma unroll
            for (int it = 0; it < 8; ++it) { const int mid = (lo + hi) >> 1; const bool open = lo < hi, lt = open && st[o * 128 + (mid < 127 ? mid : 127)].x < lim; lo = lt ? mid + 1 : lo; hi = (open && !lt) ? mid : hi; }
            v2u w; w.x = e.x | ((unsigned)(tt & 1) << 14) | ((unsigned)p << 16); w.y = e.y; ml2[(tt >> 1) * 256 + p + lo] = w;
        }
}
__device__ __forceinline__ void merge_entries(char* lds, int wave, int lane) {
    const v2u* st = (const v2u*)(lds + L_STAB) + (size_t)(4 * wave) * 128; v2u* ml = (v2u*)(lds + L_TAB) + (size_t)(4 * wave) * 128;
#pragma unroll 1
    for (int tt = 0; tt < 4; ++tt)
#pragma unroll
        for (int half = 0; half < 2; ++half) {
            const int p = lane + 64 * half; const v2u e = st[tt * 128 + p]; int rank = p;
#pragma unroll
            for (int oo = 1; oo < 4; ++oo) { const int o = (tt + oo) & 3;
                const unsigned lim = o < tt ? e.x + 1u : e.x;
                int lo = 0, hi = 128;
#pragma unroll
                for (int it = 0; it < 8; ++it) { const int mid = (lo + hi) >> 1; const bool open = lo < hi, lt = open && st[o * 128 + (mid < 127 ? mid : 127)].x < lim; lo = lt ? mid + 1 : lo; hi = (open && !lt) ? mid : hi; }
                rank += lo; }
            v2u w; w.x = e.x | ((unsigned)tt << 14) | ((unsigned)p << 16); w.y = e.y; ml[rank] = w;
        }
}
#define P8_ISSUE1(buf, rs_, idv, e) do { const unsigned so_ = ((unsigned)__builtin_amdgcn_readlane((int)(idv), lane_of(e)) & 16383u) * (unsigned)F6_ROW;     \
        const v4u a_ = __builtin_amdgcn_raw_buffer_load_b128(rs_, voff, so_, 0); const v2u b_ = __builtin_amdgcn_raw_buffer_load_b64(rs_, voffb, so_, 0); buf = (v6u){a_.x, a_.y, a_.z, a_.w, b_.x, b_.y}; } while (0)
#define P8_PIN1(buf, dep_) asm volatile("" : "+v"(buf) : "v"(dep_) : "memory")
#define P8_CVB(w_, sel_) __builtin_bit_cast(unsigned, __builtin_amdgcn_cvt_scalef32_pk_bf16_fp8((unsigned)(w_), 1.0f, sel_))
#define P8_DOT4(w_, xlo_, xhi_) do { d_ = dot2(P8_CVB(w_, false), (xlo_), d_); d_ = dot2(P8_CVB(w_, true), (xhi_), d_); } while (0)
#define P8_DOTX(buf, xr) do { _Pragma("unroll") for (int j_ = 0; j_ < 2; ++j_) { P8_DOT4(buf[j_].x, xr[2 * j_].x, xr[2 * j_].y); P8_DOT4(buf[j_].y, xr[2 * j_].z, xr[2 * j_].w); \
                                                            P8_DOT4(buf[j_].z, xr[2 * j_ + 1].x, xr[2 * j_ + 1].y); P8_DOT4(buf[j_].w, xr[2 * j_ + 1].z, xr[2 * j_ + 1].w); } } while (0)
#define P8_DOT1T(buf, e, dep_) do { P8_PIN1(buf, dep_); float d_ = 0.f; const int tt_ = (__builtin_amdgcn_readlane((int)ent.x, lane_of(e)) >> 14) & 3;     \
        if (tt_ == 0) P8_DOTX(buf, xr0); else if (tt_ == 1) P8_DOTX(buf, xr1); else if (tt_ == 2) P8_DOTX(buf, xr2); else P8_DOTX(buf, xr3); \
        pd[e] = d_; } while (0)
#define P8_CVT(w_, lo_, hi_) const auto lo_ = __builtin_amdgcn_cvt_pk_f32_fp8((int)(w_), false); const auto hi_ = __builtin_amdgcn_cvt_pk_f32_fp8((int)(w_), true)
typedef float f32x2_t __attribute__((ext_vector_type(2)));
#define P8_PKFMA(accp_, w2_, x2_) asm("v_pk_fma_f32 %0, %1, %2, %0" : "+v"(accp_) : "s"(w2_), "v"(x2_))
#define P8_FMA4(acc, w_, k_) do { const f32x2_t l2_ = __builtin_amdgcn_cvt_pk_f32_fp8((int)(w_), false), h2_ = __builtin_amdgcn_cvt_pk_f32_fp8((int)(w_), true); \
        P8_PKFMA(acc[(k_) >> 1], ws2_, l2_); P8_PKFMA(acc[((k_) >> 1) + 1], ws2_, h2_); } while (0)
#define P8_PINQ(a_, b_, dep_) asm volatile("" : "+v"(a_), "+v"(b_) : "v"(dep_))
typedef float v32f_t __attribute__((ext_vector_type(32)));
#define P8_FMAX(buf, acc) do { const v32f_t f_ = __builtin_amdgcn_cvt_scalef32_pk32_f32_fp6(buf, 1.0f);     \
        _Pragma("unroll") for (int j_ = 0; j_ < 16; ++j_) { const f32x2_t x2_ = {f_[2 * j_], f_[2 * j_ + 1]}; P8_PKFMA(acc[j_], ws2_, x2_); } vdep = acc[15].y; } while (0)
#define P8_FMA1T(buf, e) do { P8_PIN1(buf, vdep); const unsigned wsb_ = (unsigned)__builtin_amdgcn_readlane((int)__float_as_uint(wl), lane_of(e)); \
        const unsigned long long ws2_ = ((unsigned long long)wsb_ << 32) | wsb_;     \
        const int tt_ = (__builtin_amdgcn_readlane((int)ent.x, lane_of(e)) >> 14) & 1;     \
        if (tt_ == 0) P8_FMAX(buf, acc0); else P8_FMAX(buf, acc1); } while (0)
template <bool OUT16>
__device__ __forceinline__ void mix8(const bf16_t* xn, const float* partss, const unsigned char* eu_l, const unsigned char* ev_l, const float* us_l, const float* vs_l, const float* x1, float* xout,
                                     int tok0, const char* lds, int wave, int lane) {
    const int myslot = slot_of(lane); const unsigned voff = (unsigned)lane * 16u;
    const __amdgpu_buffer_rsrc_t ru = __builtin_amdgcn_make_buffer_rsrc((void*)eu_l, 0, NEXP * F6_ROW, 0x00020000), rv = __builtin_amdgcn_make_buffer_rsrc((void*)ev_l, 0, NEXP * F6_ROW, 0x00020000);
    const v2u* ml = (const v2u*)(lds + L_TAB) + (size_t)(4 * wave) * 128;
    const v2u* stw = (const v2u*)(lds + L_STAB) + (size_t)(4 * wave) * 128;
    float* wls = (float*)(lds + L_LIST) + wave * 512;
    const int t0 = tok0 + 4 * wave;
    v6u r0, r1, r2, r3, r4, r5, r6, r7; const unsigned voffb = 1024u + (unsigned)lane * 8u;
    {
        typedef int v8i_t __attribute__((ext_vector_type(8))); typedef int v4i_t __attribute__((ext_vector_type(4)));
        typedef int v6i_t __attribute__((ext_vector_type(6))); typedef int v2i_t __attribute__((ext_vector_type(2)));
        v6i_t tokA0, tokA1, tokA2, tokA3;
        float st0, st1, st2, st3;
#define P8_TOK(dst, sc_, tt_) do { float f_[32]; float am_ = 0.f; _Pragma("unroll") for (int i = 0; i < 4; ++i) { const v4u w = *(const v4u*)(xn + (size_t)(t0 + (tt_)) * DM + (size_t)(i >> 1) * 1024 + 16 * lane + 8 * (i & 1)); \
              f_[8 * i] = bflo(w.x); f_[8 * i + 1] = bfhi(w.x); f_[8 * i + 2] = bflo(w.y); f_[8 * i + 3] = bfhi(w.y); f_[8 * i + 4] = bflo(w.z); f_[8 * i + 5] = bfhi(w.z); f_[8 * i + 6] = bflo(w.w); f_[8 * i + 7] = bfhi(w.w); } \
          _Pragma("unroll") for (int i = 0; i < 32; ++i) am_ = fmaxf(am_, fabsf(f_[i])); \
          _Pragma("unroll") for (int o = 1; o < 64; o <<= 1) am_ = fmaxf(am_, __shfl_xor(am_, o)); \
          const float inv_ = am_ > 0.f ? 7.5f / am_ : 0.f; v32h_t h_; _Pragma("unroll") for (int i = 0; i < 32; ++i) h_[i] = (_Float16)(f_[i] * inv_); \
          dst = __builtin_bit_cast(v6i_t, __builtin_amdgcn_cvt_scalef32_pk32_fp6_f16(h_, 1.0f)); sc_ = am_ * (1.0f / 7.5f); } while (0)
        P8_TOK(tokA0, st0, 0); P8_TOK(tokA1, st1, 1); P8_TOK(tokA2, st2, 2); P8_TOK(tokA3, st3, 3);
#undef P8_TOK
        const float rs0 = row_rstd(partss, t0) * st0, rs1 = row_rstd(partss, t0 + 1) * st1, rs2 = row_rstd(partss, t0 + 2) * st2, rs3 = row_rstd(partss, t0 + 3) * st3;
        const int one8 = 0x7F7F7F7F, rsel = lane & 3; const bool isdiag = ((lane & 15) >> 2) == (lane >> 4);
        v6i_t u0, u1, u2, u3, u4, u5, u6, u7;
#define P8_LDRU(dst, idv, e) do { const unsigned so_ = ((unsigned)__builtin_amdgcn_readlane((int)(idv), lane_of(e)) & 16383u) * (unsigned)F6_ROW; \
            const v4i_t a_ = __builtin_bit_cast(v4i_t, __builtin_amdgcn_raw_buffer_load_b128(ru, voff, so_, 0)); const v2i_t b_ = __builtin_bit_cast(v2i_t, __builtin_amdgcn_raw_buffer_load_b64(ru, voffb, so_, 0)); \
            dst = (v6i_t){a_[0], a_[1], a_[2], a_[3], b_[0], b_[1]}; } while (0)
#define P8_MMA1(tok_, b_, k_) asm volatile("s_nop 1\n\tv_mfma_scale_f32_16x16x128_f8f6f4 %0, %1, %2, %0, %3, %3 op_sel_hi:[0,0,0] cbsz:2 blgp:2" : "+v"(d##k_) : "v"(tok_), "v"(b_), "v"(one8))
#define P8_MMT(b_, k_) do { const int tt_ = (__builtin_amdgcn_readlane((int)ent.x, lane_of(k_)) >> 14) & 3;     \
            if (tt_ < 2) { if (tt_ == 0) P8_MMA1(tokA0, b_, k_); else P8_MMA1(tokA1, b_, k_); } else { if (tt_ == 2) P8_MMA1(tokA2, b_, k_); else P8_MMA1(tokA3, b_, k_); } } while (0)
        { const unsigned idn = ml[myslot].x;
          P8_LDRU(u0, idn, 0); P8_LDRU(u1, idn, 1); P8_LDRU(u2, idn, 2); P8_LDRU(u3, idn, 3); P8_LDRU(u4, idn, 4); P8_LDRU(u5, idn, 5); P8_LDRU(u6, idn, 6); P8_LDRU(u7, idn, 7); }
#pragma unroll 1
        for (int g = 0; g < 32; ++g) {
            const v2u ent = ml[g * 16 + myslot];
            const unsigned eid = ent.x & 16383u, ett = (ent.x >> 14) & 3u, epos = ent.x >> 16;
            const v2u sc_ = *(const v2u*)(us_l + 2 * (size_t)eid); const float su = __uint_as_float(sc_.x), sv = __uint_as_float(sc_.y);
            const unsigned entn = ml[(g == 31 ? g : g + 1) * 16 + myslot].x;
            f32x4 d0 = {0.f, 0.f, 0.f, 0.f}, d1 = {0.f, 0.f, 0.f, 0.f}, d2 = {0.f, 0.f, 0.f, 0.f}, d3 = {0.f, 0.f, 0.f, 0.f}, d4 = {0.f, 0.f, 0.f, 0.f}, d5 = {0.f, 0.f, 0.f, 0.f}, d6 = {0.f, 0.f, 0.f, 0.f}, d7 = {0.f, 0.f, 0.f, 0.f}, d8 = {0.f, 0.f, 0.f, 0.f}, d9 = {0.f, 0.f, 0.f, 0.f}, d10 = {0.f, 0.f, 0.f, 0.f}, d11 = {0.f, 0.f, 0.f, 0.f}, d12 = {0.f, 0.f, 0.f, 0.f}, d13 = {0.f, 0.f, 0.f, 0.f}, d14 = {0.f, 0.f, 0.f, 0.f}, d15 = {0.f, 0.f, 0.f, 0.f};
            P8_MMT(u0, 0); P8_LDRU(u0, ent.x, 8);
            P8_MMT(u1, 1); P8_LDRU(u1, ent.x, 9);
            P8_MMT(u2, 2); P8_LDRU(u2, ent.x, 10);
            P8_MMT(u3, 3); P8_LDRU(u3, ent.x, 11);
            P8_MMT(u4, 4); P8_LDRU(u4, ent.x, 12);
            P8_MMT(u5, 5); P8_LDRU(u5, ent.x, 13);
            P8_MMT(u6, 6); P8_LDRU(u6, ent.x, 14);
            P8_MMT(u7, 7); P8_LDRU(u7, ent.x, 15);
            P8_MMT(u0, 8); P8_LDRU(u0, entn, 0);
            P8_MMT(u1, 9); P8_LDRU(u1, entn, 1);
            P8_MMT(u2, 10); P8_LDRU(u2, entn, 2);
            P8_MMT(u3, 11); P8_LDRU(u3, entn, 3);
            P8_MMT(u4, 12); P8_LDRU(u4, entn, 4);
            P8_MMT(u5, 13); P8_LDRU(u5, entn, 5);
            P8_MMT(u6, 14); P8_LDRU(u6, entn, 6);
            P8_MMT(u7, 15); P8_LDRU(u7, entn, 7);
            asm volatile("s_nop 15\n\ts_nop 3" : "+v"(d0), "+v"(d1), "+v"(d2), "+v"(d3), "+v"(d4), "+v"(d5), "+v"(d6), "+v"(d7), "+v"(d8), "+v"(d9), "+v"(d10), "+v"(d11), "+v"(d12), "+v"(d13), "+v"(d14), "+v"(d15));
            float pd[16];
            pd[0] = isdiag ? (rsel == 0 ? d0[0] : rsel == 1 ? d0[1] : rsel == 2 ? d0[2] : d0[3]) : 0.f;
            pd[1] = isdiag ? (rsel == 0 ? d1[0] : rsel == 1 ? d1[1] : rsel == 2 ? d1[2] : d1[3]) : 0.f;
            pd[2] = isdiag ? (rsel == 0 ? d2[0] : rsel == 1 ? d2[1] : rsel == 2 ? d2[2] : d2[3]) : 0.f;
            pd[3] = isdiag ? (rsel == 0 ? d3[0] : rsel == 1 ? d3[1] : rsel == 2 ? d3[2] : d3[3]) : 0.f;
            pd[4] = isdiag ? (rsel == 0 ? d4[0] : rsel == 1 ? d4[1] : rsel == 2 ? d4[2] : d4[3]) : 0.f;
            pd[5] = isdiag ? (rsel == 0 ? d5[0] : rsel == 1 ? d5[1] : rsel == 2 ? d5[2] : d5[3]) : 0.f;
            pd[6] = isdiag ? (rsel == 0 ? d6[0] : rsel == 1 ? d6[1] : rsel == 2 ? d6[2] : d6[3]) : 0.f;
            pd[7] = isdiag ? (rsel == 0 ? d7[0] : rsel == 1 ? d7[1] : rsel == 2 ? d7[2] : d7[3]) : 0.f;
            pd[8] = isdiag ? (rsel == 0 ? d8[0] : rsel == 1 ? d8[1] : rsel == 2 ? d8[2] : d8[3]) : 0.f;
            pd[9] = isdiag ? (rsel == 0 ? d9[0] : rsel == 1 ? d9[1] : rsel == 2 ? d9[2] : d9[3]) : 0.f;
            pd[10] = isdiag ? (rsel == 0 ? d10[0] : rsel == 1 ? d10[1] : rsel == 2 ? d10[2] : d10[3]) : 0.f;
            pd[11] = isdiag ? (rsel == 0 ? d11[0] : rsel == 1 ? d11[1] : rsel == 2 ? d11[2] : d11[3]) : 0.f;
            pd[12] = isdiag ? (rsel == 0 ? d12[0] : rsel == 1 ? d12[1] : rsel == 2 ? d12[2] : d12[3]) : 0.f;
            pd[13] = isdiag ? (rsel == 0 ? d13[0] : rsel == 1 ? d13[1] : rsel == 2 ? d13[2] : d13[3]) : 0.f;
            pd[14] = isdiag ? (rsel == 0 ? d14[0] : rsel == 1 ? d14[1] : rsel == 2 ? d14[2] : d14[3]) : 0.f;
            pd[15] = isdiag ? (rsel == 0 ? d15[0] : rsel == 1 ? d15[1] : rsel == 2 ? d15[2] : d15[3]) : 0.f;
#pragma unroll
            for (int i = 0; i < 8; ++i) { const float keep = (lane & 32) ? pd[i + 8] : pd[i], send = (lane & 32) ? pd[i] : pd[i + 8]; pd[i] = keep + __shfl_xor(send, 32); }
#pragma unroll
            for (int i = 0; i < 4; ++i) { const float keep = (lane & 16) ? pd[i + 4] : pd[i], send = (lane & 16) ? pd[i] : pd[i + 4]; pd[i] = keep + __shfl_xor(send, 16); }
#pragma unroll
            for (int i = 0; i < 2; ++i) { const float keep = (lane & 8) ? pd[i + 2] : pd[i], send = (lane & 8) ? pd[i] : pd[i + 2]; pd[i] = keep + __shfl_xor(send, 8); }
            { const float keep = (lane & 4) ? pd[1] : pd[0], send = (lane & 4) ? pd[0] : pd[1]; pd[0] = keep + __shfl_xor(send, 4); }
            pd[0] += __shfl_xor(pd[0], 2); pd[0] += __shfl_xor(pd[0], 1);
            const float rs = ett == 0 ? rs0 : ett == 1 ? rs1 : ett == 2 ? rs2 : rs3;
            wls[ett * 128 + epos] = __uint_as_float(ent.y) * gelu_exact(pd[0] * (su * rs)) * sv;
        }
#undef P8_LDRU
#undef P8_MMA1
#undef P8_MMT
    }
    {
        typedef float v32f_t __attribute__((ext_vector_type(32)));
        v32f_t A0, A1, A2, A3;
#pragma unroll
        for (int i = 0; i < 32; ++i) { A0[i] = 0.f; A1[i] = 0.f; A2[i] = 0.f; A3[i] = 0.f; }
#define P8_ROWV(buf, e) do { const unsigned wsb_ = (unsigned)__builtin_amdgcn_readlane((int)__float_as_uint(wl), lane_of(e)); const unsigned long long ws2_ = ((unsigned long long)wsb_ << 32) | wsb_; \
        const unsigned off_ = (((unsigned)__builtin_amdgcn_readlane((int)ent.x, lane_of(e)) >> 14) & 3u) * 32u;     \
        v32f_t f_; asm volatile("v_cvt_scalef32_pk32_f32_fp6 v[0:31], %[p], 1.0\n\ts_set_gpr_idx_on %[off], 0xc\n\ts_nop 1\n\t" \
            "v_pk_fma_f32 v[32:33], %[w], v[0:1], v[32:33]\n\tv_pk_fma_f32 v[34:35], %[w], v[2:3], v[34:35]\n\tv_pk_fma_f32 v[36:37], %[w], v[4:5], v[36:37]\n\tv_pk_fma_f32 v[38:39], %[w], v[6:7], v[38:39]\n\t" \
            "v_pk_fma_f32 v[40:41], %[w], v[8:9], v[40:41]\n\tv_pk_fma_f32 v[42:43], %[w], v[10:11], v[42:43]\n\tv_pk_fma_f32 v[44:45], %[w], v[12:13], v[44:45]\n\tv_pk_fma_f32 v[46:47], %[w], v[14:15], v[46:47]\n\t" \
            "v_pk_fma_f32 v[48:49], %[w], v[16:17], v[48:49]\n\tv_pk_fma_f32 v[50:51], %[w], v[18:19], v[50:51]\n\tv_pk_fma_f32 v[52:53], %[w], v[20:21], v[52:53]\n\tv_pk_fma_f32 v[54:55], %[w], v[22:23], v[54:55]\n\t" \
            "v_pk_fma_f32 v[56:57], %[w], v[24:25], v[56:57]\n\tv_pk_fma_f32 v[58:59], %[w], v[26:27], v[58:59]\n\tv_pk_fma_f32 v[60:61], %[w], v[28:29], v[60:61]\n\tv_pk_fma_f32 v[62:63], %[w], v[30:31], v[62:63]\n\t" \
            "s_set_gpr_idx_off" \
            : "+{v[32:63]}"(A0), "+{v[64:95]}"(A1), "+{v[96:127]}"(A2), "+{v[128:159]}"(A3), "=&{v[0:31]}"(f_) : [p] "v"(buf), [w] "s"(ws2_), [off] "s"(off_) : "memory"); } while (0)
        { const unsigned idn = ml[myslot].x;
          P8_ISSUE1(r0, rv, idn, 0); P8_ISSUE1(r1, rv, idn, 1); P8_ISSUE1(r2, rv, idn, 2); P8_ISSUE1(r3, rv, idn, 3); P8_ISSUE1(r4, rv, idn, 4); P8_ISSUE1(r5, rv, idn, 5); P8_ISSUE1(r6, rv, idn, 6); P8_ISSUE1(r7, rv, idn, 7); }
#pragma unroll 1
        for (int g = 0; g < 32; ++g) {
            const v2u ent = ml[g * 16 + myslot];
            const float wl = wls[((ent.x >> 14) & 3u) * 128 + (ent.x >> 16)];
            const unsigned entn = ml[(g == 31 ? g : g + 1) * 16 + myslot].x;
            P8_ROWV(r0, 0); P8_ISSUE1(r0, rv, ent.x, 8);
            P8_ROWV(r1, 1); P8_ISSUE1(r1, rv, ent.x, 9);
            P8_ROWV(r2, 2); P8_ISSUE1(r2, rv, ent.x, 10);
            P8_ROWV(r3, 3); P8_ISSUE1(r3, rv, ent.x, 11);
            P8_ROWV(r4, 4); P8_ISSUE1(r4, rv, ent.x, 12);
            P8_ROWV(r5, 5); P8_ISSUE1(r5, rv, ent.x, 13);
            P8_ROWV(r6, 6); P8_ISSUE1(r6, rv, ent.x, 14);
            P8_ROWV(r7, 7); P8_ISSUE1(r7, rv, ent.x, 15);
            P8_ROWV(r0, 8); P8_ISSUE1(r0, rv, entn, 0);
            P8_ROWV(r1, 9); P8_ISSUE1(r1, rv, entn, 1);
            P8_ROWV(r2, 10); P8_ISSUE1(r2, rv, entn, 2);
            P8_ROWV(r3, 11); P8_ISSUE1(r3, rv, entn, 3);
            P8_ROWV(r4, 12); P8_ISSUE1(r4, rv, entn, 4);
            P8_ROWV(r5, 13); P8_ISSUE1(r5, rv, entn, 5);
            P8_ROWV(r6, 14); P8_ISSUE1(r6, rv, entn, 6);
            P8_ROWV(r7, 15); P8_ISSUE1(r7, rv, entn, 7);
        }
        int lo = 16 * lane; asm volatile("" : "+v"(lo) :: "memory");
#define P8_OUT(A, tt_) do { _Pragma("unroll") for (int hf = 0; hf < 2; ++hf) _Pragma("unroll") for (int i = 0; i < 4; i += 2) { const size_t o = (size_t)(t0 + (tt_)) * DM + hf * 1024 + lo + 4 * i; \
            const v4u a = *(const v4u*)(xn + o); f32x4 r, q; const int b_ = (hf * 8 + 2 * i) * 2; \
            r.x = bflo(a.x) + A[b_]; r.y = bfhi(a.x) + A[b_ + 1]; r.z = bflo(a.y) + A[b_ + 2]; r.w = bfhi(a.y) + A[b_ + 3]; \
            q.x = bflo(a.z) + A[b_ + 4]; q.y = bfhi(a.z) + A[b_ + 5]; q.z = bflo(a.w) + A[b_ + 6]; q.w = bfhi(a.w) + A[b_ + 7]; \
            if (OUT16) { v4u w_; w_.x = pk2(r.x, r.y); w_.y = pk2(r.z, r.w); w_.z = pk2(q.x, q.y); w_.w = pk2(q.z, q.w); *(v4u*)((bf16_t*)xout + o) = w_; } \
            else { *(f32x4*)(xout + o) = r; *(f32x4*)(xout + o + 4) = q; } } } while (0)
        P8_OUT(A0, 0); P8_OUT(A1, 1); P8_OUT(A2, 2); P8_OUT(A3, 3);
#undef P8_OUT
#undef P8_ROWV
    }
}
#undef P8_ISSUE1
#undef P8_PIN1
#undef P8_CVB
#undef P8_DOT4
#undef P8_DOTX
#undef P8_DOT1T
#undef P8_CVT
#undef P8_FMA4
#undef P8_PINQ
#undef P8_FMAX
#undef P8_PKFMA
#undef P8_FMA1T
}
template <bool NEXT_NORM>
__device__ __forceinline__ void phase_peer(const bf16_t* xn, const float* partss, const bf16_t* query, const bf16_t* sk_l, const unsigned char* eu_l, const unsigned char* ev_l, const float* us_l, const float* vs_l, const float* x1, float* xout,
                                           const float* ngain, const float* nwin, const float* nbf, float* nlogf, bf16_t* nxn, const Ctx& c) {
    if (NEXT_NORM) {
        const f32x4* src = (const f32x4*)nwin; LAS f32x4* dstl = (LAS f32x4*)(c.lds + peer::L_STAB);
#pragma unroll
        for (int i = 0; i < 8 * DM / 4 / NTHREADS; ++i) dstl[c.tid + NTHREADS * i] = src[c.tid + NTHREADS * i];
        __syncthreads();
    }
    for (int chunk = blockIdx.x; chunk < T / peer::CH; chunk += gridDim.x) {
        const int tok0 = chunk * peer::CH;
        int lane1 = c.lane; asm volatile("" : "+v"(lane1));
        peer::route(query, sk_l, tok0, c.ldsg, c.wave, lane1);
        __syncthreads();
        int lane2 = c.lane; asm volatile("" : "+v"(lane2));
        peer::sort512(c.ldsg, c.wave, lane2);
        peer::mix8<NEXT_NORM>(xn, partss, eu_l, ev_l, us_l, vs_l, x1, xout, tok0, c.ldsg, c.wave, lane2);
        if (NEXT_NORM) {
            int lane3 = c.lane; asm volatile("" : "+v"(lane3));
            rmsnorm_rows4<const LAS float*, true>(xout, ngain, nxn, (const LAS float*)(c.lds + peer::L_STAB), nbf, nlogf, lane3, tok0 + 4 * c.wave);
        }
        __syncthreads();
    }
}

typedef const __attribute__((address_space(4))) Args* KArgs;
__device__ __forceinline__ KArgs opq(KArgs p) { asm volatile("" : "+s"(p)); return p; }
#define FRESH() do { int w_ = c.wave; unsigned z_ = 0u; asm volatile("" : "+s"(w_), "+v"(z_)); \
        c.tid = (w_ << 6) | (int)__builtin_amdgcn_mbcnt_hi(~0u, __builtin_amdgcn_mbcnt_lo(~0u, z_)); asm volatile("" : "+v"(c.tid)); c.lane = c.tid & 63; ka = opq(ka); } while (0)
#define WSP(T_, off) ((T_*)(ka->ws + (off)))

template <int l>
__device__ __forceinline__ void layer_body(KArgs ka, const Ctx& c_in, const XcdBarrier& bar) {
    Ctx c = c_in;
    FRESH();
    if (l == 0) {
#ifndef SKIP_P1
    { phase_rmsnorm4(ka->in[I_X], ka->in[I_MIXN], WSP(bf16_t, WS_XN8), ka->in[I_WIN], ka->in[I_BF], WSP(float, WS_LOGF), c); }
#endif
    xcd_barrier(bar, c.tid); FRESH();
    }
#ifndef SKIP_P2
    { pg8::Gemm g{WSP(const bf16_t, WS_XN8), (const bf16_t*)(WSP(const unsigned char, WS_WIN) + (size_t)l * NPACK * DM), T, NPACK, DM / 2};
      StaticOrderConv S; S.init(T, NPACK, (int)gridDim.x, (int)blockIdx.x); S.pick();
      {
        const int G_ = (int)gridDim.x, c_ = (int)blockIdx.x; int per, base;
        if (G_ == 256 && NEXP == 16384) { if (c_ < 192) { per = 7; base = c_ * 56; } else { per = 11; base = 192 * 56 + (c_ - 192) * 88; } base += c.wave * per; }
        else { const int nwv = G_ * NWAVES; per = (NEXP + nwv - 1) / nwv; base = (c_ * NWAVES + c.wave) * per; }
        S.row0 = l * NEXP + (base < NEXP ? base : NEXP); S.rowend = l * NEXP + (base + per < NEXP ? base + per : NEXP); S.rstride = G_ * NWAVES; }
      S.wit0 = l + 1 < DEPTH ? (int)blockIdx.x * NWAVES + c.wave : -1;
      S.w_in = ka->in[I_WIN] + (size_t)(l + 1) * DM * IN_COLS; S.w_ba = ka->in[I_WBA] + (size_t)(l + 1) * A_OUT * DM; S.w_bb = ka->in[I_WBB] + (size_t)(l + 1) * B_OUT * DM; S.w_out = ka->in[I_WOUT] + (size_t)(l + 1) * DM * DM;
      S.w_in8 = WSP(unsigned char, WS_WIN) + (size_t)(l + 1) * NPACK * DM; S.w_ba8 = WSP(unsigned char, WS_WBA) + (size_t)(l + 1) * DM * A_OUT; S.w_bb8 = WSP(unsigned char, WS_WBB) + (size_t)(l + 1) * DM * B_OUT; S.w_out8 = WSP(unsigned char, WS_WOUT) + (size_t)(l + 1) * DM * DM;
      S.eu = ka->in[I_EU]; S.ev = ka->in[I_EV]; S.eu6 = WSP(unsigned char, WS_EU); S.ev6 = WSP(unsigned char, WS_EV); S.scl = WSP(float, WS_EUS); S.gain = ka->in[I_FFNN];
      decay_cumsum(WSP(const float, WS_LOGF), WSP(float, WS_KBIAS), WSP(float, WS_ZBIAS), c);
      EpiProjFused E{WSP(bf16_t, WS_Q), WSP(bf16_t, WS_K), WSP(bf16_t, WS_V), WSP(bf16_t, WS_GATE), ka->in[I_QN] + (size_t)l * NHEADS * HD, ka->in[I_KN] + (size_t)l * NHEADS * HD, WSP(const float, WS_ROT), c.lds, ka->in[I_BG] + (size_t)l * 2 * DM};
      pg8::gemm_phase<EpiProjFused, StaticOrderConv, true, true, true>(c.lds, g, S, E, c.tid); }
#endif
    xcd_barrier(bar, c.tid); FRESH();
#ifndef SKIP_P4
#ifdef ATT_NAIVE
    phase_attn_naive(WSP(const bf16_t, WS_Q), WSP(const bf16_t, WS_K), WSP(const bf16_t, WS_V), WSP(const float, WS_KBIAS), WSP(bf16_t, WS_OA), WSP(bf16_t, WS_OB), c);
#else
    { AttPtrs P{WSP(const bf16_t, WS_Q), WSP(const bf16_t, WS_K), WSP(const bf16_t, WS_V), WSP(const float, WS_KBIAS), WSP(const float, WS_ZBIAS),
                 WSP(bf16_t, WS_PROJ), WSP(bf16_t, WS_PROJ + 8 * MiB), WSP(float, WS_PROJ + 16 * MiB), WSP(float, WS_PROJ + 17 * MiB), (bf16_t*)WSP(unsigned char, WS_MERGED + 16 * MiB)};
      phase_attn(P, c.ldsg, c.tid); }
#endif
#endif
    xcd_barrier(bar, c.tid); FRESH();
#ifndef SKIP_P4
    phase_attn_combine(WSP(const bf16_t, WS_PROJ), WSP(const bf16_t, WS_PROJ + 8 * MiB), WSP(const float, WS_PROJ + 16 * MiB), WSP(const float, WS_PROJ + 17 * MiB), WSP(unsigned char, WS_OA), WSP(const bf16_t, WS_OB), WSP(unsigned char, WS_MERGED + 16 * MiB), c);
#endif
    xcd_barrier(bar, c.tid); FRESH();
#ifndef SKIP_P5
    { pg8::StaticOrder S; S.init(T, DM, (int)gridDim.x, (int)blockIdx.x);
      { pg8::OneUnit S1; if (S.next(0, S1.u)) {
        pg8::f32x4 acc[2][2][4][2];
        { pg8::Gemm g{WSP(const bf16_t, WS_OA), (const bf16_t*)(WSP(const unsigned char, WS_WBA) + (size_t)l * DM * A_OUT), T, DM, A_OUT / 2};
          EpiBranchScale E{WSP(const bf16_t, WS_GATE)};
          pg8::gemm_phase_acc<EpiBranchScale, pg8::OneUnit, true, true, true, true, O_SHIFT>(c.lds, g, S1, E, c.tid, acc); }
        { pg8::Gemm g{WSP(const bf16_t, WS_MERGED + 16 * MiB), (const bf16_t*)(WSP(const unsigned char, WS_WBB) + (size_t)l * DM * B_OUT), T, DM, B_OUT / 2};
          EpiBranchOut E{WSP(bf16_t, WS_MERGED), (const bf16_t*)(WSP(const unsigned char, WS_GATE) + DM)};
          pg8::gemm_phase_acc<EpiBranchOut, pg8::OneUnit, true, true, true, false, O_SHIFT>(c.lds, g, S1, E, c.tid, acc); }
      } } }
#endif
    xcd_barrier(bar, c.tid); FRESH();
#ifndef SKIP_P6
    { const float* xin = l == 0 ? ka->in[I_X] : WSP(const float, WS_XCUR);
      pg8::Gemm g{WSP(const bf16_t, WS_MERGED), (const bf16_t*)(WSP(const unsigned char, WS_WOUT) + (size_t)l * DM * DM), T, DM, DM / 2}; pg8::StaticOrder S; S.init(T, DM, (int)gridDim.x, (int)blockIdx.x);
      EpiResidualNorm<(l > 0)> E{xin, WSP(bf16_t, WS_XN), WSP(float, WS_PARTSS), c.lds, WSP(unsigned char, WS_X1)};
      pg8::gemm_phase<EpiResidualNorm<(l > 0)>, pg8::StaticOrder, true, true, true, MRG_SHIFT>(c.lds, g, S, E, c.tid); }
#endif
    xcd_barrier(bar, c.tid); FRESH();
#ifndef SKIP_P8
    { pg8::Gemm g{WSP(const bf16_t, WS_X1), (const bf16_t*)(WSP(const unsigned char, WS_WQ) + (size_t)l * DM * DM), T, DM, DM / 2}; pg8::StaticOrder S; S.init(T, DM, (int)gridDim.x, (int)blockIdx.x);
      EpiBf16RowScale E{WSP(bf16_t, WS_QUERY), DM, WSP(const float, WS_PARTSS)};
      pg8::gemm_phase<EpiBf16RowScale, pg8::StaticOrder, true, true, true, X1_SHIFT>(c.lds, g, S, E, c.tid); }
#endif
    xcd_barrier(bar, c.tid); FRESH();
#ifndef SKIP_P9
    { float* xout = l == DEPTH - 1 ? ka->out : WSP(float, WS_XCUR);
      phase_peer<(l + 1 < DEPTH)>(WSP(const bf16_t, WS_XN), WSP(const float, WS_PARTSS), WSP(const bf16_t, WS_QUERY), WSP(const bf16_t, WS_SK) + (size_t)l * PEER_HEADS * 2 * NKEYS * HD,
                 WSP(const unsigned char, WS_EU) + (size_t)l * NEXP * F6_ROW, WSP(const unsigned char, WS_EV) + (size_t)l * NEXP * F6_ROW,
                 WSP(const float, WS_EUS) + (size_t)l * NEXP * 2, WSP(const float, WS_EUS) + (size_t)l * NEXP * 2, WSP(const float, WS_X1), xout,
                 ka->in[I_MIXN] + (size_t)(l + 1 < DEPTH ? l + 1 : l) * DM, WSP(const float, WS_WF) + (size_t)(l + 1 < DEPTH ? l + 1 : l) * 8 * DM, ka->in[I_BF] + (l + 1 < DEPTH ? l + 1 : l) * FOX_HEADS,
                 WSP(float, WS_LOGF), WSP(bf16_t, WS_XN8), c); }
#endif
    if (l + 1 < DEPTH) xcd_barrier(bar, c.tid);
}

__global__ void __launch_bounds__(NTHREADS, 2) fwd_kernel(Args a_unused) {
    extern __shared__ __attribute__((aligned(16))) unsigned char lds_raw[];
    (void)a_unused;
    KArgs ka = (KArgs)__builtin_amdgcn_kernarg_segment_ptr();
    Ctx c; c.lds = (LAS unsigned char*)lds_raw; c.ldsg = (char*)lds_raw; c.tid = threadIdx.x; c.lane = c.tid & 63; c.wave = __builtin_amdgcn_readfirstlane(c.tid >> 6);
    c.gw = blockIdx.x * NWAVES + c.wave; c.ngw = gridDim.x * NWAVES;
    volatile LAS unsigned* misc = (volatile LAS unsigned*)(c.lds + MISC_OFF);
    if (c.tid < 64) misc[c.tid] = 0u;
    __syncthreads();
    XcdBarrier bar = xcd_barrier_post((unsigned*)(ka->ws + WS_CTL) + CW_BAR, misc + 8, c.tid);
#ifndef SKIP_P0
    phase_convert(ka, c);
#endif
    layer_body<0>(ka, c, bar);
    layer_body<1>(ka, c, bar);
}
#undef FRESH
#undef WSP

extern "C" void kernel_launch(void* const* d_in, const int* in_sizes, int n_in, void* d_out, int out_size, void* d_ws, size_t ws_size, hipStream_t stream) {
    static int grid = 0;
    if (grid == 0) {
        if (n_in != 15 || out_size != T * DM || ws_size < WS_END) {
            fprintf(stderr, "kernel_launch: unexpected shapes (n_in %d, out %d, ws %zu, need %zu); nothing launched\n", n_in, out_size, ws_size, (size_t)WS_END); grid = -1; return; }
        int dev = 0, cus = 0;
        if (hipGetDevice(&dev) != hipSuccess || hipDeviceGetAttribute(&cus, hipDeviceAttributeMultiprocessorCount, dev) != hipSuccess || cus <= 0) cus = 256;
        if (hipFuncSetAttribute((const void*)fwd_kernel, hipFuncAttributeMaxDynamicSharedMemorySize, LDS_BYTES) != hipSuccess) { fprintf(stderr, "kernel_launch: hipFuncSetAttribute failed\n"); grid = -1; return; }
        int per_cu = 0;
        if (hipOccupancyMaxActiveBlocksPerMultiprocessor(&per_cu, (const void*)fwd_kernel, NTHREADS, LDS_BYTES) != hipSuccess || per_cu < 1)
            fprintf(stderr, "kernel_launch: occupancy query says %d workgroups per CU\n", per_cu);
        (void)hipGetLastError();
        grid = cus;
    }
    if (grid < 0) return;
    (void)in_sizes;
    if (hipMemsetAsync((char*)d_ws + WS_CTL, 0, CTL_ZERO_BYTES, stream) != hipSuccess) { fprintf(stderr, "kernel_launch: memset failed\n"); return; }
    Args a{};
    for (int i = 0; i < 15; ++i) a.in[i] = (const float*)d_in[i];
    a.out = (float*)d_out; a.ws = (unsigned char*)d_ws;
    hipLaunchKernelGGL(fwd_kernel, dim3(grid), dim3(NTHREADS), LDS_BYTES, stream, a);
}
```

```cpp
#include <hip/hip_runtime.h>
#include <cstdio>
#include <cstdint>

constexpr int DM = 2048, NBATCH = 4, SEQ = 2048, DEPTH = 2, HD = 128;
constexpr int T = NBATCH * SEQ;
constexpr int DIL_HEADS = 12, FOX_HEADS = 8, NHEADS = 20;
constexpr int QKV_COLS = 3 * NHEADS * HD;
constexpr int IN_COLS = QKV_COLS + FOX_HEADS + 2 * DM;
constexpr int GATE_COL0 = QKV_COLS + FOX_HEADS;
constexpr int NPACK = QKV_COLS + 2 * DM;
constexpr int A_OUT = 512, B_OUT = 1024;
constexpr int PEER_HEADS = 8, NKEYS = 128, NEXP = NKEYS * NKEYS, TOPK = 16;
constexpr float RMS_EPS = 1e-6f;
constexpr float LOG2E = 1.4426950408889634f;
constexpr float QSCALE = 0.08838834764831845f * LOG2E;

constexpr size_t MiB = 1u << 20;
constexpr size_t WS_CTL = 0, CTL_ZERO_BYTES = 1 * MiB;
constexpr size_t WS_WF = 512 * 1024;
constexpr size_t WS_WIN = 1 * MiB;
constexpr size_t WS_WBA = 93 * MiB;
constexpr size_t WS_WBB = 97 * MiB;
constexpr size_t WS_WOUT = 105 * MiB;
constexpr size_t WS_WQ = 121 * MiB;
constexpr size_t WS_SK = 137 * MiB;
constexpr size_t WS_EU = 138 * MiB;
constexpr size_t WS_EV = 266 * MiB;
constexpr size_t WS_EUS = 202 * MiB;
constexpr size_t WS_EVS = 330 * MiB;
constexpr size_t WS_XN = 394 * MiB;
constexpr size_t WS_PROJ = 426 * MiB;
constexpr size_t WS_GATE = 546 * MiB;
constexpr size_t WS_Q = 610 * MiB, WS_K = 650 * MiB, WS_V = 690 * MiB;
constexpr size_t WS_OA = 730 * MiB;
constexpr size_t WS_OB = 738 * MiB;
constexpr size_t WS_MERGED = 754 * MiB;
constexpr size_t WS_X1 = 786 * MiB;
constexpr size_t WS_QUERY = 850 * MiB;
constexpr size_t WS_XCUR = 882 * MiB;
constexpr size_t WS_LOGF = 946 * MiB;
constexpr size_t WS_PARTSS = WS_LOGF + 512 * 1024;
constexpr size_t WS_KBIAS = 947 * MiB;
constexpr size_t WS_ZBIAS = WS_KBIAS + 512 * 1024;
constexpr size_t WS_XN8 = 948 * MiB;
constexpr size_t WS_ROT = 964 * MiB;
constexpr size_t WS_END = 965 * MiB;
constexpr int MRG_SHIFT = 4, X1_SHIFT = 3, O_SHIFT = 5, GATE_SHIFT = 4;
constexpr int WIN_SHIFT = 6;
constexpr int CW_BAR = 4096;

constexpr int NWAVES = 8, NTHREADS = NWAVES * 64;
constexpr int LDS_BYTES = 147456;
constexpr int MISC_OFF = 131072;

#define LAS __attribute__((address_space(3)))
typedef unsigned short bf16_t;
typedef unsigned v4u __attribute__((ext_vector_type(4)));
typedef unsigned v2u __attribute__((ext_vector_type(2)));
typedef float f32x4 __attribute__((ext_vector_type(4)));
typedef __bf16 bf16x2_t __attribute__((ext_vector_type(2)));
#define LDS_WAIT() asm volatile("s_waitcnt lgkmcnt(0)" ::: "memory")

__device__ __forceinline__ float bf2f(unsigned b) { return __uint_as_float(b << 16); }
__device__ __forceinline__ float bflo(unsigned w) { return __uint_as_float(w << 16); }
__device__ __forceinline__ float bfhi(unsigned w) { return __uint_as_float(w & 0xffff0000u); }
__device__ __forceinline__ unsigned f2bf(float f) { unsigned u = __float_as_uint(f); return (u + 0x7fffu + ((u >> 16) & 1u)) >> 16; }
__device__ __forceinline__ unsigned pk2(float lo, float hi) { return f2bf(lo) | (f2bf(hi) << 16); }
__device__ __forceinline__ float dot2(unsigned a, unsigned b, float acc) {
    return __builtin_amdgcn_fdot2_f32_bf16(__builtin_bit_cast(bf16x2_t, a), __builtin_bit_cast(bf16x2_t, b), acc, false);
}
__device__ __forceinline__ float wave_sum(float v) {
#pragma unroll
    for (int o = 1; o < 64; o <<= 1) v += __shfl_xor(v, o);
    return v;
}
__device__ __forceinline__ unsigned wave_max_u(unsigned v) {
#pragma unroll
    for (int o = 1; o < 64; o <<= 1) { unsigned t = (unsigned)__shfl_xor((int)v, o); v = t > v ? t : v; }
    return v;
}
__device__ __forceinline__ unsigned ord_f(float f) { unsigned u = __float_as_uint(f); return (u & 0x80000000u) ? ~u : (u | 0x80000000u); }
__device__ __forceinline__ float unord_f(unsigned u) { return __uint_as_float((u & 0x80000000u) ? (u & 0x7fffffffu) : ~u); }

#define XB_TMO      128
#define XB_XCNT(j)  (256  + 64 * (j))
#define XB_XSUB(j)  (1280 + 64 * (j))
#define XB_XGEN(j)  (2304 + 64 * (j))
#define XB_TOP      3328
#define XB_TOPGEN   3392
#define XCD_BAR_WORDS 3456
#define XB_SPIN_CAP (1u << 22)

__device__ __forceinline__ unsigned xb_ld(unsigned* p)              { return __hip_atomic_load(p, __ATOMIC_RELAXED, __HIP_MEMORY_SCOPE_AGENT); }
__device__ __forceinline__ unsigned xb_add(unsigned* p, unsigned v) { return __hip_atomic_fetch_add(p, v, __ATOMIC_RELAXED, __HIP_MEMORY_SCOPE_AGENT); }
__device__ __forceinline__ unsigned xb_xcc_id() { return (unsigned)__builtin_amdgcn_s_getreg((3 << 11) | 20) & 0xFu; }
#define XB_SPIN(cond, bar) do { unsigned _sp = 0; while (cond) { __builtin_amdgcn_s_sleep(1); \
    if ((++_sp & 255u) == 0u) { if (xb_ld(&(bar)[XB_TMO])) break; if (_sp > XB_SPIN_CAP) { atomicAdd(&(bar)[XB_TMO], 1u); break; } } } } while (0)

struct XcdBarrier { unsigned* bar; unsigned x; volatile LAS unsigned* st; };

__device__ __forceinline__ XcdBarrier xcd_barrier_post(unsigned* bar, volatile LAS unsigned* st, const int tid) {
    XcdBarrier b; b.bar = bar; b.x = xb_xcc_id(); b.st = st;
    if (tid == 0) (void)xb_add(&bar[XB_XCNT(b.x)], 1u);
    return b;
}
__device__ __forceinline__ void xcd_barrier_complete(unsigned* bar, unsigned x, unsigned& nloc, unsigned& nx) {
    const unsigned G = gridDim.x * gridDim.y * gridDim.z;
    unsigned sum, cnt, mine, sp = 0u;
    for (;;) {
        sum = 0u; cnt = 0u; mine = 0u;
#pragma unroll
        for (unsigned j = 0; j < 16; ++j) { const unsigned c = xb_ld(&bar[XB_XCNT(j)]); sum += c; cnt += (c > 0u) ? 1u : 0u; mine = (j == x) ? c : mine; }
        if (sum == G) break;
        __builtin_amdgcn_s_sleep(1);
        if ((++sp & 255u) == 0u) { if (xb_ld(&bar[XB_TMO])) break; if (sp > XB_SPIN_CAP) { atomicAdd(&bar[XB_TMO], 1u); break; } }
    }
    nloc = mine > 0u ? mine : 1u; nx = cnt > 0u ? cnt : 1u;
}
__device__ __forceinline__ void xcd_barrier(const XcdBarrier& b, const int tid) {
    asm volatile("s_waitcnt vmcnt(0)" ::: "memory");
    __syncthreads();
    if (tid == 0) {
        unsigned* bar = b.bar;
        __builtin_amdgcn_s_waitcnt(0);
        unsigned nloc = b.st[0], nx = b.st[1];
        if (nloc == 0u) { xcd_barrier_complete(bar, b.x, nloc, nx); b.st[0] = nloc; b.st[1] = nx; }
        const unsigned old = xb_add(&bar[XB_XSUB(b.x)], 1u);
        const unsigned gen = old / nloc;
        if (old + 1u == (gen + 1u) * nloc) {
            __builtin_amdgcn_fence(__ATOMIC_RELEASE, "agent");
            asm volatile("s_waitcnt vmcnt(0)" ::: "memory");
            const unsigned og = xb_add(&bar[XB_TOP], 1u);
            const unsigned tg = og / nx;
            if (og + 1u == (tg + 1u) * nx) xb_add(&bar[XB_TOPGEN], 1u);
            else XB_SPIN(xb_ld(&bar[XB_TOPGEN]) == tg, bar);
            __builtin_amdgcn_fence(__ATOMIC_ACQUIRE, "agent");
            xb_add(&bar[XB_XGEN(b.x)], 1u);
            asm volatile("s_waitcnt vmcnt(0)" ::: "memory");
        } else {
            XB_SPIN(xb_ld(&bar[XB_XGEN(b.x)]) == gen, bar);
            __builtin_amdgcn_fence(__ATOMIC_ACQUIRE, "agent");
            asm volatile("s_waitcnt vmcnt(0)" ::: "memory");
        }
    }
    __syncthreads();
}

struct Args {
    const float* in[15];
    float* out;
    unsigned char* ws;
};
enum { I_X = 0, I_MIXN, I_WIN, I_BF, I_BG, I_QN, I_KN, I_WBA, I_WBB, I_WOUT, I_FFNN, I_WQ, I_SK, I_EU, I_EV };

struct Ctx { int tid, lane, wave, gw, ngw; LAS unsigned char* lds; char* ldsg; };

typedef short p0_bf16x8 __attribute__((ext_vector_type(8)));
typedef float p0_f32x16 __attribute__((ext_vector_type(16)));
__device__ __forceinline__ void transpose_item(const float* W, int ld, int col0, int K, int N, bf16_t* WT, int row_off, LAS float* scr, int item, int lane, const float* kgain = nullptr) {
    const int nblk = N / 32, kb = item / nblk, nb = item % nblk, k0 = 64 * kb, n0 = 32 * nb;
#pragma unroll
    for (int i = 0; i < 32; ++i) { const int kk = 2 * i + (lane >> 5); scr[kk * 33 + (lane & 31)] = W[(size_t)(k0 + kk) * ld + col0 + n0 + (lane & 31)] * (kgain ? kgain[k0 + kk] : 1.0f); }
    LDS_WAIT();
    const int c = lane & 7;
#pragma unroll
    for (int j = 0; j < 4; ++j) { const int n = (lane >> 3) + 8 * j; const LAS float* s = scr + (8 * c) * 33 + n;
        v4u o; o.x = pk2(s[0 * 33], s[1 * 33]); o.y = pk2(s[2 * 33], s[3 * 33]); o.z = pk2(s[4 * 33], s[5 * 33]); o.w = pk2(s[6 * 33], s[7 * 33]);
        *(v4u*)(WT + (size_t)(row_off + n0 + n) * K + k0 + 8 * c) = o; }
    LDS_WAIT();
}
__device__ __forceinline__ int qk_perm_col(int col) {
    if (col >= 2 * NHEADS * HD) return col;
    const int d = col & 127, hb = col & ~127;
    return hb + (d < 64 ? 8 * (d >> 2) + (d & 3) : 8 * ((d - 64) >> 2) + 4 + (d & 3));
}
template <bool QKPERM>
__device__ __forceinline__ void transpose_item_fp8(const float* W, int ld, int col0, int K, int N, unsigned char* WT, int row_off, LAS float* scr, int item, int lane, const float* kgain = nullptr) {
    const int nblk = N / 32, kb = item / nblk, nb = item % nblk, k0 = 64 * kb, n0 = 32 * nb;
#pragma unroll
    for (int i = 0; i < 32; ++i) { const int kk = 2 * i + (lane >> 5); scr[kk * 33 + (lane & 31)] = W[(size_t)(k0 + kk) * ld + col0 + n0 + (lane & 31)] * (kgain ? kgain[k0 + kk] : 1.0f); }
    LDS_WAIT();
    constexpr float SC = (float)(1 << WIN_SHIFT);
#pragma unroll
    for (int j = 0; j < 2; ++j) { const int id = lane + 64 * j, n = id >> 2, c = id & 3; const LAS float* sp = scr + (16 * c) * 33 + n;
        v4u o;
#pragma unroll
        for (int i = 0; i < 4; ++i) { int w = __builtin_amdgcn_cvt_pk_fp8_f32(sp[(4 * i) * 33] * SC, sp[(4 * i + 1) * 33] * SC, 0, false); w = __builtin_amdgcn_cvt_pk_fp8_f32(sp[(4 * i + 2) * 33] * SC, sp[(4 * i + 3) * 33] * SC, w, true);
            if (i == 0) o.x = (unsigned)w; else if (i == 1) o.y = (unsigned)w; else if (i == 2) o.z = (unsigned)w; else o.w = (unsigned)w; }
        const int drow = QKPERM ? qk_perm_col(n0 + n) : n0 + n;
        *(v4u*)(WT + (size_t)(row_off + drow) * K + k0 + 16 * c) = o; }
    LDS_WAIT();
}
__device__ __forceinline__ void convert_flat(const float* src, bf16_t* dst, size_t n, const Ctx& c) {
    const size_t n8 = n / 8, stride = (size_t)gridDim.x * NTHREADS;
    for (size_t i = (size_t)blockIdx.x * NTHREADS + c.tid; i < n8; i += stride) {
        const f32x4 a = *(const f32x4*)(src + i * 8), b = *(const f32x4*)(src + i * 8 + 4);
        v4u o; o.x = pk2(a.x, a.y); o.y = pk2(a.z, a.w); o.z = pk2(b.x, b.y); o.w = pk2(b.z, b.w);
        *(v4u*)(dst + i * 8) = o;
    }
}
__device__ __forceinline__ void convert_fp8_rows(const float* src, unsigned char* dst, float* scales, int nrows, const Ctx& c, const float* cgain = nullptr) {
    for (int row = c.gw; row < nrows; row += c.ngw) {
        const float* sp = src + (size_t)row * DM + 16 * c.lane;
        const float* gp = cgain ? cgain + (size_t)(row / NEXP) * DM + 16 * c.lane : nullptr;
        f32x4 v[8]; float am = 0.f;
#pragma unroll
        for (int hf = 0; hf < 2; ++hf)
#pragma unroll
            for (int i = 0; i < 4; ++i) { f32x4 x = *(const f32x4*)(sp + hf * 1024 + 4 * i); if (gp) x *= *(const f32x4*)(gp + hf * 1024 + 4 * i); v[hf * 4 + i] = x;
                am = fmaxf(am, fmaxf(fmaxf(fabsf(x.x), fabsf(x.y)), fmaxf(fabsf(x.z), fabsf(x.w)))); }
#pragma unroll
        for (int o = 1; o < 64; o <<= 1) am = fmaxf(am, __shfl_xor(am, o));
        const float inv = am > 0.f ? 240.0f / am : 0.f;
#pragma unroll
        for (int hf = 0; hf < 2; ++hf) { v4u o;
#pragma unroll
            for (int i = 0; i < 4; ++i) { const f32x4 x = v[hf * 4 + i];
                int w = __builtin_amdgcn_cvt_pk_fp8_f32(x.x * inv, x.y * inv, 0, false); w = __builtin_amdgcn_cvt_pk_fp8_f32(x.z * inv, x.w * inv, w, true);
                if (i == 0) o.x = (unsigned)w; else if (i == 1) o.y = (unsigned)w; else if (i == 2) o.z = (unsigned)w; else o.w = (unsigned)w; }
            *(v4u*)(dst + (size_t)row * DM + hf * 1024 + 16 * c.lane) = o; }
        if (c.lane == 0) scales[row] = am > 0.f ? am * (1.0f / 240.0f) : 1.0f;
    }
}
constexpr int F6_ROW = 1536;
typedef unsigned v6u __attribute__((ext_vector_type(6)));
typedef _Float16 v32h_t __attribute__((ext_vector_type(32)));
__device__ __forceinline__ void convert_fp6_rows(const float* src, unsigned char* dst, float* scales, int nrows, const Ctx& c, const float* cgain = nullptr) {
    f32x4 nx[8];
    if (c.gw < nrows) {
#pragma unroll
        for (int i = 0; i < 8; ++i) nx[i] = *(const f32x4*)(src + (size_t)c.gw * DM + 16 * c.lane + (i >> 2) * 1024 + 4 * (i & 3));
    }
#pragma unroll 1
    for (int row = c.gw; row < nrows; row += c.ngw) {
        const float* gp = cgain ? cgain + (size_t)(row / NEXP) * DM + 16 * c.lane : nullptr;
        f32x4 v[8]; float am = 0.f;
#pragma unroll
        for (int i = 0; i < 8; ++i) v[i] = nx[i];
        { const int rn = row + c.ngw < nrows ? row + c.ngw : row;
#pragma unroll
          for (int i = 0; i < 8; ++i) nx[i] = *(const f32x4*)(src + (size_t)rn * DM + 16 * c.lane + (i >> 2) * 1024 + 4 * (i & 3)); }
#pragma unroll
        for (int i = 0; i < 8; ++i) { f32x4 x = v[i]; if (gp) x *= *(const f32x4*)(gp + (i >> 2) * 1024 + 4 * (i & 3)); v[i] = x;
            am = fmaxf(am, fmaxf(fmaxf(fabsf(x.x), fabsf(x.y)), fmaxf(fabsf(x.z), fabsf(x.w)))); }
#pragma unroll
        for (int o = 1; o < 64; o <<= 1) am = fmaxf(am, __shfl_xor(am, o));
        const float inv = am > 0.f ? 7.5f / am : 0.f;
        v32h_t h;
#pragma unroll
        for (int j = 0; j < 8; ++j) { h[4 * j] = (_Float16)(v[j].x * inv); h[4 * j + 1] = (_Float16)(v[j].y * inv); h[4 * j + 2] = (_Float16)(v[j].z * inv); h[4 * j + 3] = (_Float16)(v[j].w * inv); }
        const v6u p = __builtin_amdgcn_cvt_scalef32_pk32_fp6_f16(h, 1.0f);
        unsigned char* rp = dst + (size_t)row * F6_ROW;
        *(v4u*)(rp + 16 * c.lane) = (v4u){p[0], p[1], p[2], p[3]}; *(v2u*)(rp + 1024 + 8 * c.lane) = (v2u){p[4], p[5]};
        if (c.lane == 0) scales[2 * (size_t)row] = am > 0.f ? am * (1.0f / 7.5f) : 1.0f;
    }
}
__device__ __forceinline__ void transpose_item64(const float* W, int ld, int col0, int K, int N, unsigned char* WT, int row_off, bool perm, int item, int lane) {
    const int nblk = N / 64, kb = item / nblk, nb = item - kb * nblk, k0 = 64 * kb, n = 64 * nb + lane;
    const float* wp = W + (size_t)k0 * ld + col0 + 64 * nb;
    float x[64];
#pragma unroll
    for (int kk = 0; kk < 64; ++kk) x[kk] = *(const float*)((const char*)(wp + (size_t)kk * ld) + (unsigned)(lane * 4));
    constexpr float SC = (float)(1 << WIN_SHIFT);
    unsigned char* op = WT + (size_t)(row_off + (perm ? qk_perm_col(n) : n)) * K + k0;
#pragma unroll
    for (int j = 0; j < 4; ++j) { v4u o;
#pragma unroll
        for (int i = 0; i < 4; ++i) { const int b = 16 * j + 4 * i; int w = __builtin_amdgcn_cvt_pk_fp8_f32(x[b] * SC, x[b + 1] * SC, 0, false); w = __builtin_amdgcn_cvt_pk_fp8_f32(x[b + 2] * SC, x[b + 3] * SC, w, true);
            if (i == 0) o.x = (unsigned)w; else if (i == 1) o.y = (unsigned)w; else if (i == 2) o.z = (unsigned)w; else o.w = (unsigned)w; }
        *(v4u*)(op + 16 * j) = o; }
}
constexpr int T64_IN0 = (DM / 64) * (QKV_COLS / 64), T64_IN1 = (DM / 64) * (2 * DM / 64), T64_BA = (A_OUT / 64) * (DM / 64), T64_BB = (B_OUT / 64) * (DM / 64), T64_OUT = (DM / 64) * (DM / 64),
              T64_LAYER = T64_IN0 + T64_IN1 + T64_BA + T64_BB + T64_OUT;
__device__ __forceinline__ void transpose_layer_item64(const float* win, const float* wba, const float* wbb, const float* wout, unsigned char* win8, unsigned char* wba8, unsigned char* wbb8, unsigned char* wout8, int r, int lane) {
    const float* W; int ld, col0, K, N, row_off = 0; unsigned char* WT; bool perm = false;
    if (r < T64_IN0) { W = win; ld = IN_COLS; col0 = 0; K = DM; N = QKV_COLS; WT = win8; perm = true; }
    else if ((r -= T64_IN0) < T64_IN1) { W = win; ld = IN_COLS; col0 = GATE_COL0; K = DM; N = 2 * DM; WT = win8; row_off = QKV_COLS; }
    else if ((r -= T64_IN1) < T64_BA) { W = wba; ld = DM; col0 = 0; K = A_OUT; N = DM; WT = wba8; }
    else if ((r -= T64_BA) < T64_BB) { W = wbb; ld = DM; col0 = 0; K = B_OUT; N = DM; WT = wbb8; }
    else { r -= T64_BB; W = wout; ld = DM; col0 = 0; K = DM; N = DM; WT = wout8; }
    transpose_item64(W, ld, col0, K, N, WT, row_off, perm, r, lane);
}
__device__ __forceinline__ void convert_fp6_rows_b4(const float* src, unsigned char* dst, float* scales, int row0, int rstride, int rowend, int lane, const float* cgain = nullptr) {
#pragma unroll 1
    for (int rb = row0; rb < rowend; rb += 4 * rstride) {
        f32x4 v[4][8];
#pragma unroll
        for (int q = 0; q < 4; ++q) { const int rq = rb + q * rstride < rowend ? rb + q * rstride : rb;
#pragma unroll
            for (int i = 0; i < 8; ++i) v[q][i] = *(const f32x4*)(src + (size_t)rq * DM + 16 * lane + (i >> 2) * 1024 + 4 * (i & 3)); }
#pragma unroll
        for (int q = 0; q < 4; ++q) { const int row = rb + q * rstride;
            const float* gp = cgain ? cgain + (size_t)(rb / NEXP) * DM + 16 * lane : nullptr; float am = 0.f;
#pragma unroll
            for (int i = 0; i < 8; ++i) { f32x4 x = v[q][i]; if (gp) x *= *(const f32x4*)(gp + (i >> 2) * 1024 + 4 * (i & 3)); v[q][i] = x;
                am = fmaxf(am, fmaxf(fmaxf(fabsf(x.x), fabsf(x.y)), fmaxf(fabsf(x.z), fabsf(x.w)))); }
#pragma unroll
            for (int o = 1; o < 64; o <<= 1) am = fmaxf(am, __shfl_xor(am, o));
            const float inv = am > 0.f ? 7.5f / am : 0.f;
            v32h_t h;
#pragma unroll
            for (int j = 0; j < 8; ++j) { h[4 * j] = (_Float16)(v[q][j].x * inv); h[4 * j + 1] = (_Float16)(v[q][j].y * inv); h[4 * j + 2] = (_Float16)(v[q][j].z * inv); h[4 * j + 3] = (_Float16)(v[q][j].w * inv); }
            const v6u p = __builtin_amdgcn_cvt_scalef32_pk32_fp6_f16(h, 1.0f);
            if (row < rowend) { unsigned char* rp = dst + (size_t)row * F6_ROW;
                *(v4u*)(rp + 16 * lane) = (v4u){p[0], p[1], p[2], p[3]}; *(v2u*)(rp + 1024 + 8 * lane) = (v2u){p[4], p[5]};
                if (lane == 0) scales[2 * (size_t)row] = am > 0.f ? am * (1.0f / 7.5f) : 1.0f; }
        }
    }
}
__device__ __forceinline__ void phase_convert(const __attribute__((address_space(4))) Args* ka, const Ctx& c0) {
    Ctx c = c0; c.gw = blockIdx.x * NWAVES + c0.wave; c.ngw = gridDim.x * NWAVES;
    constexpr int NTH = NTHREADS;
    LAS float* scr = (LAS float*)(c.lds + c.wave * 16384);
    constexpr int I_IN0 = (DM / 64) * (QKV_COLS / 32), I_IN1 = (DM / 64) * (2 * DM / 32), I_BA = (A_OUT / 64) * (DM / 32), I_BB = (B_OUT / 64) * (DM / 32),
                  I_OUT = (DM / 64) * (DM / 32), I_LAYER = I_IN0 + I_IN1 + I_BA + I_BB + I_OUT;
    unsigned char* win8 = (unsigned char*)(ka->ws + WS_WIN); bf16_t* wba_t = (bf16_t*)(ka->ws + WS_WBA); bf16_t* wbb_t = (bf16_t*)(ka->ws + WS_WBB);
    bf16_t* wout_t = (bf16_t*)(ka->ws + WS_WOUT); bf16_t* wq_t = (bf16_t*)(ka->ws + WS_WQ);
    for (int it = c.gw; it < (DEPTH - 1) * 0 + I_LAYER; it += c.ngw) {
        const int l = it / I_LAYER; int r = it - l * I_LAYER;
        const float* win = ka->in[I_WIN] + (size_t)l * DM * IN_COLS;
        if (r < I_IN0) { transpose_item_fp8<true>(win, IN_COLS, 0, DM, QKV_COLS, win8 + (size_t)l * NPACK * DM, 0, scr, r, c.lane); continue; } r -= I_IN0;
        if (r < I_IN1) { transpose_item_fp8<false>(win, IN_COLS, GATE_COL0, DM, 2 * DM, win8 + (size_t)l * NPACK * DM, QKV_COLS, scr, r, c.lane); continue; } r -= I_IN1;
        if (r < I_BA) { transpose_item_fp8<false>(ka->in[I_WBA] + (size_t)l * A_OUT * DM, DM, 0, A_OUT, DM, (unsigned char*)wba_t + (size_t)l * DM * A_OUT, 0, scr, r, c.lane); continue; } r -= I_BA;
        if (r < I_BB) { transpose_item_fp8<false>(ka->in[I_WBB] + (size_t)l * B_OUT * DM, DM, 0, B_OUT, DM, (unsigned char*)wbb_t + (size_t)l * DM * B_OUT, 0, scr, r, c.lane); continue; } r -= I_BB;
        { transpose_item_fp8<false>(ka->in[I_WOUT] + (size_t)l * DM * DM, DM, 0, DM, DM, (unsigned char*)wout_t + (size_t)l * DM * DM, 0, scr, r, c.lane); continue; }
    }
    { float* rot = (float*)(ka->ws + WS_ROT);
      for (int i = blockIdx.x * NTH + c.tid; i < SEQ * 64; i += gridDim.x * NTH) { const int pos = i >> 6, fi = i & 63;
          float sn, cs; sincosf((float)pos * exp2f(-(float)fi * (13.287712379549449f / 64.0f)), &sn, &cs); rot[i] = cs; rot[SEQ * 64 + i] = sn; } }
    { float* wfg = (float*)(ka->ws + WS_WF);
      for (int i = blockIdx.x * NTH + c.tid; i < DEPTH * DM; i += gridDim.x * NTH) { const int l = i / DM, k = i % DM; const float* wp = ka->in[I_WIN] + ((size_t)l * DM + k) * IN_COLS + QKV_COLS;
          const f32x4 w0 = *(const f32x4*)wp, w1 = *(const f32x4*)(wp + 4); float* d = wfg + (size_t)l * 8 * DM + k;
          d[0] = w0.x; d[DM] = w0.y; d[2 * DM] = w0.z; d[3 * DM] = w0.w; d[4 * DM] = w1.x; d[5 * DM] = w1.y; d[6 * DM] = w1.z; d[7 * DM] = w1.w; } }
    { bf16_t* wqk = (bf16_t*)(ka->ws + WS_WQ); const int r32 = c.lane & 31, hi = c.lane >> 5;
      for (int it = c.gw; it < DEPTH * 16 * 64 * 4; it += c.ngw) {
          const int l = it >> 12, rr = it & 4095, hh = rr >> 8, kt = (rr >> 2) & 63, jt = rr & 3;
          const float* skp = ka->in[I_SK] + ((size_t)(l * 16 + hh) * NKEYS + jt * 32 + r32) * HD + 8 * hi;
          const float* wqp = ka->in[I_WQ] + (size_t)l * DM * DM + (size_t)(kt * 32 + r32) * DM + hh * HD + 8 * hi;
          const float g = ka->in[I_FFNN][(size_t)l * DM + kt * 32 + r32];
          p0_f32x16 acc = {};
#pragma unroll
          for (int sidx = 0; sidx < 8; ++sidx) {
              const f32x4 a0 = *(const f32x4*)(skp + 16 * sidx), a1 = *(const f32x4*)(skp + 16 * sidx + 4), b0 = *(const f32x4*)(wqp + 16 * sidx) * g, b1 = *(const f32x4*)(wqp + 16 * sidx + 4) * g;
              const p0_bf16x8 av = __builtin_bit_cast(p0_bf16x8, (v4u){pk2(a0.x, a0.y), pk2(a0.z, a0.w), pk2(a1.x, a1.y), pk2(a1.z, a1.w)});
              const p0_bf16x8 bv = __builtin_bit_cast(p0_bf16x8, (v4u){pk2(b0.x, b0.y), pk2(b0.z, b0.w), pk2(b1.x, b1.y), pk2(b1.z, b1.w)});
              acc = __builtin_amdgcn_mfma_f32_32x32x16_bf16(av, bv, acc, 0, 0, 0); }
          unsigned char* op = (unsigned char*)wqk + (size_t)l * DM * DM + (size_t)(hh * HD + hi * 64 + jt * 16) * DM + kt * 32 + r32;
#pragma unroll
          for (int r = 0; r < 16; ++r) op[(size_t)r * DM] = (unsigned char)(__builtin_amdgcn_cvt_pk_fp8_f32(acc[r] * (float)(1 << WIN_SHIFT), 0.f, 0, false) & 0xff); } }
}

__device__ __forceinline__ float log_sigmoid(float z) { return fminf(z, 0.f) - log1pf(expf(-fabsf(z))); }
template <bool LOGF>
__device__ __forceinline__ void rmsnorm_row(const float* xin, const float* gain, bf16_t* out, const float* win_l, const float* bf_l, float* logf, const Ctx& c, const int row) {
    {
        const f32x4* xr = (const f32x4*)(xin + (size_t)row * DM) + c.lane;
        f32x4 v[8]; float ss = 0.f;
#pragma unroll
        for (int j = 0; j < 8; ++j) { v[j] = xr[64 * j]; ss += (v[j].x * v[j].x + v[j].y * v[j].y) + (v[j].z * v[j].z + v[j].w * v[j].w); }
        ss = wave_sum(ss);
        const float rstd = 1.0f / sqrtf(ss * (1.0f / DM) + RMS_EPS);
#pragma unroll
        for (int j = 0; j < 8; ++j) {
            const f32x4 g = ((const f32x4*)gain)[c.lane + 64 * j];
            if (LOGF) {
                int w = __builtin_amdgcn_cvt_pk_fp8_f32(v[j].x * rstd * g.x, v[j].y * rstd * g.y, 0, false); w = __builtin_amdgcn_cvt_pk_fp8_f32(v[j].z * rstd * g.z, v[j].w * rstd * g.w, w, true);
                ((unsigned*)((unsigned char*)out + (size_t)row * DM))[c.lane + 64 * j] = (unsigned)w;
            } else { v2u o; o.x = pk2(v[j].x * rstd * g.x, v[j].y * rstd * g.y); o.y = pk2(v[j].z * rstd * g.z, v[j].w * rstd * g.w); ((v2u*)(out + (size_t)row * DM))[c.lane + 64 * j] = o; }
        }
        float f[8] = {0.f, 0.f, 0.f, 0.f, 0.f, 0.f, 0.f, 0.f};
        if (LOGF) {
#pragma unroll 1
            for (int j = 0; j < 8; ++j) {
                const f32x4 xv = xr[64 * j], g = ((const f32x4*)gain)[c.lane + 64 * j];
                const float y[4] = {xv.x * rstd * g.x, xv.y * rstd * g.y, xv.z * rstd * g.z, xv.w * rstd * g.w};
#pragma unroll
                for (int e = 0; e < 4; ++e) {
                    const int k = 4 * c.lane + 256 * j + e;
                    const f32x4 w0 = *(const f32x4*)(win_l + (size_t)k * IN_COLS + QKV_COLS), w1 = *(const f32x4*)(win_l + (size_t)k * IN_COLS + QKV_COLS + 4);
                    f[0] += y[e] * w0.x; f[1] += y[e] * w0.y; f[2] += y[e] * w0.z; f[3] += y[e] * w0.w; f[4] += y[e] * w1.x; f[5] += y[e] * w1.y; f[6] += y[e] * w1.z; f[7] += y[e] * w1.w;
                }
            }
        }
        if (LOGF) {
#pragma unroll
            for (int h = 0; h < 8; ++h) { const float s = wave_sum(f[h]); if (c.lane == h) logf[(size_t)row * 8 + h] = log_sigmoid(s + bf_l[h]); }
        }
    }
}

template <bool XB16> __device__ __forceinline__ f32x4 ld_x4(const float* base, size_t elem) {
    if (XB16) { const v2u w = *(const v2u*)((const bf16_t*)base + elem); return (f32x4){bflo(w.x), bfhi(w.x), bflo(w.y), bfhi(w.y)}; }
    return *(const f32x4*)(base + elem);
}
template <class WP, bool XB16 = false>
__device__ __forceinline__ void rmsnorm_rows4(const float* xin, const float* gain, bf16_t* out, WP wf, const float* bf_l, float* logf, const int lane, const int row0) {
    float rstd[4];
#pragma unroll
    for (int q = 0; q < 4; ++q) {
        f32x4 v[8]; float ss = 0.f;
#pragma unroll
        for (int j = 0; j < 8; ++j) { v[j] = ld_x4<XB16>(xin, (size_t)(row0 + q) * DM + 4 * (lane + 64 * j)); ss += (v[j].x * v[j].x + v[j].y * v[j].y) + (v[j].z * v[j].z + v[j].w * v[j].w); }
        ss = wave_sum(ss);
        const float rs = __builtin_amdgcn_rsqf(ss * (1.0f / DM) + RMS_EPS); rstd[q] = rs;
#pragma unroll
        for (int j = 0; j < 8; ++j) { const f32x4 g = ((const f32x4*)gain)[lane + 64 * j];
            int w = __builtin_amdgcn_cvt_pk_fp8_f32(v[j].x * rs * g.x, v[j].y * rs * g.y, 0, false); w = __builtin_amdgcn_cvt_pk_fp8_f32(v[j].z * rs * g.z, v[j].w * rs * g.w, w, true);
            ((unsigned*)((unsigned char*)out + (size_t)(row0 + q) * DM))[lane + 64 * j] = (unsigned)w; }
        asm volatile("" ::: "memory");
    }
    float f[32];
#pragma unroll
    for (int i = 0; i < 32; ++i) f[i] = 0.f;
#pragma unroll 1
    for (int j = 0; j < 8; ++j) {
        const f32x4 g = ((const f32x4*)gain)[lane + 64 * j];
        f32x4 y[4];
#pragma unroll
        for (int q = 0; q < 4; ++q) { const f32x4 xv = ld_x4<XB16>(xin, (size_t)(row0 + q) * DM + 4 * (lane + 64 * j)); y[q] = xv * rstd[q] * g; }
#pragma unroll
        for (int h = 0; h < 8; ++h) { const f32x4 w = *(const f32x4*)(wf + h * DM + 4 * lane + 256 * j);
#pragma unroll
            for (int q = 0; q < 4; ++q) f[q * 8 + h] += (y[q].x * w.x + y[q].y * w.y) + (y[q].z * w.z + y[q].w * w.w); }
    }
#pragma unroll
    for (int i = 0; i < 16; ++i) { const float keep = (lane & 32) ? f[i + 16] : f[i], send = (lane & 32) ? f[i] : f[i + 16]; f[i] = keep + __shfl_xor(send, 32); }
#pragma unroll
    for (int i = 0; i < 8; ++i) { const float keep = (lane & 16) ? f[i + 8] : f[i], send = (lane & 16) ? f[i] : f[i + 8]; f[i] = keep + __shfl_xor(send, 16); }
#pragma unroll
    for (int i = 0; i < 4; ++i) { const float keep = (lane & 8) ? f[i + 4] : f[i], send = (lane & 8) ? f[i] : f[i + 4]; f[i] = keep + __shfl_xor(send, 8); }
#pragma unroll
    for (int i = 0; i < 2; ++i) { const float keep = (lane & 4) ? f[i + 2] : f[i], send = (lane & 4) ? f[i] : f[i + 2]; f[i] = keep + __shfl_xor(send, 4); }
    { const float keep = (lane & 2) ? f[1] : f[0], send = (lane & 2) ? f[0] : f[1]; f[0] = keep + __shfl_xor(send, 2); }
    f[0] += __shfl_xor(f[0], 1);
    if ((lane & 1) == 0) { const int idx = lane >> 1, q = idx >> 3, h = idx & 7; logf[(size_t)(row0 + q) * 8 + h] = log_sigmoid(f[0] + bf_l[h]); }
}
__device__ __forceinline__ void phase_rmsnorm4(const float* xin, const float* gain, bf16_t* out, const float* win_l, const float* bf_l, float* logf, const Ctx& c) {
    LAS float* wfl = (LAS float*)c.lds;
    __syncthreads();
#pragma unroll 1
    for (int i = 0; i < DM / NTHREADS; ++i) { const int k = c.tid + NTHREADS * i;
        const f32x4 w0 = *(const f32x4*)(win_l + (size_t)k * IN_COLS + QKV_COLS), w1 = *(const f32x4*)(win_l + (size_t)k * IN_COLS + QKV_COLS + 4);
        wfl[0 * DM + k] = w0.x; wfl[1 * DM + k] = w0.y; wfl[2 * DM + k] = w0.z; wfl[3 * DM + k] = w0.w; wfl[4 * DM + k] = w1.x; wfl[5 * DM + k] = w1.y; wfl[6 * DM + k] = w1.z; wfl[7 * DM + k] = w1.w; }
    __syncthreads();
    for (int g = c.gw; g < T / 4; g += c.ngw) rmsnorm_rows4<const LAS float*>(xin, gain, out, (const LAS float*)wfl, bf_l, logf, c.lane, 4 * g);
    __syncthreads();
}
template <bool LOGF>
__device__ __forceinline__ void phase_rmsnorm(const float* xin, const float* gain, bf16_t* out, const float* win_l, const float* bf_l, float* logf, const Ctx& c) {
    for (int row = c.gw; row < T; row += c.ngw) rmsnorm_row<LOGF>(xin, gain, out, win_l, bf_l, logf, c, row);
}

template <class Epi>
__device__ __forceinline__ void gemm_naive(const bf16_t* A, const bf16_t* Bt, int M, int N, int K, const Epi& epi, const Ctx& c) {
    const int tm = c.tid >> 5, tn = c.tid & 31, ntn = N / 32, ntiles = (M / 16) * ntn;
    for (int tile = blockIdx.x; tile < ntiles; tile += gridDim.x) {
        const int row = (tile / ntn) * 16 + tm, col = (tile % ntn) * 32 + tn;
        const v4u* ap = (const v4u*)(A + (size_t)row * K); const v4u* bp = (const v4u*)(Bt + (size_t)col * K);
        float a0 = 0.f, a1 = 0.f, a2 = 0.f, a3 = 0.f;
#pragma unroll 4
        for (int k = 0; k < K / 8; ++k) { const v4u va = ap[k], vb = bp[k]; a0 = dot2(va.x, vb.x, a0); a1 = dot2(va.y, vb.y, a1); a2 = dot2(va.z, vb.z, a2); a3 = dot2(va.w, vb.w, a3); }
        epi(row, col, (a0 + a1) + (a2 + a3));
    }
}
struct EpiProj { bf16_t* proj; bf16_t* gate;
    __device__ __forceinline__ void operator()(int row, int col, float v) const {
        if (col < QKV_COLS) proj[(size_t)row * QKV_COLS + col] = (bf16_t)f2bf(v); else gate[(size_t)row * (2 * DM) + (col - QKV_COLS)] = (bf16_t)f2bf(v); } };
struct EpiResidual { const float* xin; float* xout;
    __device__ __forceinline__ void operator()(int row, int col, float v) const { xout[(size_t)row * DM + col] = xin[(size_t)row * DM + col] + v; } };
struct EpiBf16Out { bf16_t* o; int ld;
    __device__ __forceinline__ void operator()(int row, int col, float v) const { o[(size_t)row * ld + col] = (bf16_t)f2bf(v); } };
__device__ __forceinline__ float sigmoidf(float z) { return 1.0f / (1.0f + expf(-z)); }
__device__ __forceinline__ void phase_branch_naive(const bf16_t* oa, const bf16_t* ob, const bf16_t* wba_t, const bf16_t* wbb_t, const bf16_t* gate, const float* bg_l, bf16_t* merged, const Ctx& c) {
    const int tm = c.tid >> 5, tn = c.tid & 31, ntn = DM / 32, ntiles = (T / 16) * ntn;
    for (int tile = blockIdx.x; tile < ntiles; tile += gridDim.x) {
        const int row = (tile / ntn) * 16 + tm, col = (tile % ntn) * 32 + tn;
        float accA, accB;
        { const v4u* ap = (const v4u*)(oa + (size_t)row * A_OUT); const v4u* bp = (const v4u*)(wba_t + (size_t)col * A_OUT);
          float a0 = 0.f, a1 = 0.f, a2 = 0.f, a3 = 0.f;
#pragma unroll 4
          for (int k = 0; k < A_OUT / 8; ++k) { const v4u va = ap[k], vb = bp[k]; a0 = dot2(va.x, vb.x, a0); a1 = dot2(va.y, vb.y, a1); a2 = dot2(va.z, vb.z, a2); a3 = dot2(va.w, vb.w, a3); }
          accA = (a0 + a1) + (a2 + a3); }
        { const v4u* ap = (const v4u*)(ob + (size_t)row * B_OUT); const v4u* bp = (const v4u*)(wbb_t + (size_t)col * B_OUT);
          float a0 = 0.f, a1 = 0.f, a2 = 0.f, a3 = 0.f;
#pragma unroll 4
          for (int k = 0; k < B_OUT / 8; ++k) { const v4u va = ap[k], vb = bp[k]; a0 = dot2(va.x, vb.x, a0); a1 = dot2(va.y, vb.y, a1); a2 = dot2(va.z, vb.z, a2); a3 = dot2(va.w, vb.w, a3); }
          accB = (a0 + a1) + (a2 + a3); }
        const float gA = sigmoidf(bf2f(gate[(size_t)row * (2 * DM) + col]) + bg_l[col]);
        const float gB = sigmoidf(bf2f(gate[(size_t)row * (2 * DM) + DM + col]) + bg_l[DM + col]);
        merged[(size_t)row * DM + col] = (bf16_t)f2bf(gA * accA + gB * accB);
    }
}


namespace pg8 {
#define PG8_LAS __attribute__((address_space(3)))
typedef unsigned short bf16_t;
typedef short bf16x8 __attribute__((ext_vector_type(8)));
typedef float f32x4 __attribute__((ext_vector_type(4)));
typedef unsigned u32x4 __attribute__((ext_vector_type(4)));
typedef int pg8_v4i __attribute__((ext_vector_type(4)));
typedef int pg8_v8i __attribute__((ext_vector_type(8)));
constexpr int BM = 256, BK = 64, HALF = 128, HTB = HALF * BK * 2  , STAGE_BYTES = 8 * HTB, NXCD = 8, WGM = 8;

__host__ __device__ __forceinline__ int lds_byte(int r, int c) { const int st = (r >> 4) * 2 + (c >> 5), rr = r & 15, cc = c & 31, ob = rr * 64 + cc * 2; return st * 1024 + (ob ^ (((ob >> 9) & 1) << 5)); }
__host__ __device__ __forceinline__ void stage_rc(int b, int& R, int& C) { const int st = b / 1024, sb = b % 1024, swz = sb ^ (((sb >> 9) & 1) << 5); R = (st >> 1) * 16 + swz / 64; C = (st & 1) * 32 + (swz % 64) / 2; }
__host__ __device__ __forceinline__ int perm32(int rho) { const int n = rho >> 4, i = rho & 15; return 8 * (i >> 2) + 4 * n + (i & 3); }

struct Unit { int pm, pn; };
struct Gemm { const bf16_t* A; const bf16_t* Bt; int M, N, K; };

struct StaticOrder {
    int nM, nN, nwg, G, c;
    __host__ __device__ void init(int M, int N, int G_, int c_) { nM = M / BM; nN = N / BM; nwg = nM * nN; G = G_; c = c_; }
    __host__ __device__ __forceinline__ bool next(int i, Unit& u) const {
        const long L = (long)i * G + c; if (L >= nwg) return false;
        int wgid = (int)L; { const int q = nwg / NXCD, r = nwg % NXCD, xcd = wgid % NXCD, off = wgid / NXCD; wgid = (xcd < r ? xcd * (q + 1) : r * (q + 1) + (xcd - r) * q) + off; }
        const int nig = WGM * nN, gid = wgid / nig, fm = gid * WGM, gsz = (nM - fm) < WGM ? (nM - fm) : WGM;
        u.pm = fm + ((wgid % nig) % gsz); u.pn = (wgid % nig) / gsz; return true;
    }
    __device__ __forceinline__ void a_ready(const Unit&) const {}
    __device__ __forceinline__ void done(const Unit&) const {}
};
__device__ __forceinline__ unsigned cvt_pk_bf16(float lo, float hi) { unsigned r; asm volatile("v_cvt_pk_bf16_f32 %0, %1, %2" : "=v"(r) : "v"(lo), "v"(hi)); return r; }
template <class Epi, class Sched, bool ALIGN_EPI = false, bool SP2 = false, bool FP8 = false, bool ZERO = true, int XSHIFT = 0>
__device__ __forceinline__ void gemm_phase_acc(PG8_LAS unsigned char* lds, const Gemm g, const Sched& S, const Epi& E, const int tid, f32x4 (&acc)[2][2][4][2]) {
    const int  wid = __builtin_amdgcn_readfirstlane(tid >> 6), lane = tid & 63, wr = wid >> 2, wc = wid & 3, fr = lane & 15, fq = lane >> 4;
    const int K = g.K, nt = K / BK;
    unsigned voffA[2], voffB[2];
#pragma unroll
    for (int i = 0; i < 2; ++i) { int R, C; stage_rc(tid * 16 + i * 8192, R, C); const int Rb = Epi::PERM ? ((R & ~31) + perm32(R & 31)) : R;
        voffA[i] = (unsigned)(R * K + C) * 2u; voffB[i] = (unsigned)(Rb * K + C) * 2u; }
    const size_t kstep = (size_t)(BK * 2);
    const size_t hstep = (size_t)HALF * K * 2;
    const size_t tstep = 2 * hstep;
    const unsigned ldsw = (unsigned)wid * 1024u;
    const int aoff = lds_byte(wr * 64 + fr, fq * 8), boff = lds_byte(wc * 32 + fr, fq * 8);
#define PG8_SA(b, h) (((b) * 2 + (h)) * HTB)
#define PG8_SB(b, h) ((4 + (b) * 2 + (h)) * HTB)
#define PG8_STAGE(bufoff, gbase, voff) do { _Pragma("unroll") for (int _i = 0; _i < 2; ++_i) \
        __builtin_amdgcn_global_load_lds((const unsigned*)((const char*)(gbase) + (voff)[_i]), (PG8_LAS unsigned*)(lds + (bufoff) + ldsw + _i * 8192), 16, 0, 0); } while (0)
#define PG8_LD8(p_) __builtin_shufflevector(*(const PG8_LAS pg8_v4i*)(p_), *(const PG8_LAS pg8_v4i*)((p_) + 1024), 0, 1, 2, 3, 4, 5, 6, 7)
#define PG8_LDA(dst, b, h) do { if constexpr (FP8) { _Pragma("unroll") for (int m = 0; m < 4; ++m) dst##8[m] = PG8_LD8(lds + PG8_SA(b, h) + aoff + m * 2048); } \
        else { _Pragma("unroll") for (int m = 0; m < 4; ++m) _Pragma("unroll") for (int k = 0; k < 2; ++k) dst[m][k] = *(const PG8_LAS bf16x8*)(lds + PG8_SA(b, h) + aoff + m * 2048 + k * 1024); } } while (0)
#define PG8_LDB(dst, b, h) do { if constexpr (FP8) { _Pragma("unroll") for (int n = 0; n < 2; ++n) dst##8[n] = PG8_LD8(lds + PG8_SB(b, h) + boff + n * 2048); } \
        else { _Pragma("unroll") for (int n = 0; n < 2; ++n) _Pragma("unroll") for (int k = 0; k < 2; ++k) dst[n][k] = *(const PG8_LAS bf16x8*)(lds + PG8_SB(b, h) + boff + n * 2048 + k * 1024); } } while (0)
#define PG8_MMA(ai, bj, At, Bt) do { __builtin_amdgcn_s_setprio(1); _Pragma("unroll") for (int m = 0; m < 4; ++m) _Pragma("unroll") for (int n = 0; n < 2; ++n) { \
        if constexpr (FP8) asm volatile("v_mfma_scale_f32_16x16x128_f8f6f4 %0, %1, %2, %0, %3, %4 op_sel_hi:[0,0,0]" : "+v"(acc[ai][bj][m][n]) : "v"(Bt##8[n]), "v"(At##8[m]), "v"(scale_w), "v"(scale_x));     \
        else { _Pragma("unroll") for (int k = 0; k < 2; ++k) acc[ai][bj][m][n] = __builtin_amdgcn_mfma_f32_16x16x32_bf16(Bt[n][k], At[m][k], acc[ai][bj][m][n], 0, 0, 0); } } \
        __builtin_amdgcn_s_setprio(0); } while (0)
#define PG8_WAIT_V(n) asm volatile("s_waitcnt vmcnt(" #n ")" ::: "memory")
#define PG8_WAIT_L(n) asm volatile("s_waitcnt lgkmcnt(" #n ")" ::: "memory")
#define PG8_BAR __builtin_amdgcn_s_barrier()
#define PG8_SCHED __builtin_amdgcn_sched_barrier(0)
    Unit cur, nxt; int ui = 0;
    if (!S.next(0, cur)) return;
    if constexpr (ZERO) {
#pragma unroll
    for (int a = 0; a < 2; ++a)
#pragma unroll
        for (int b = 0; b < 2; ++b)
#pragma unroll
            for (int m = 0; m < 4; ++m)
#pragma unroll
                for (int n = 0; n < 2; ++n) acc[a][b][m][n] = (f32x4){0.f, 0.f, 0.f, 0.f};
    }
    bf16x8 At[4][2], B0[2][2], B1[2][2];
    const int scale_w = (int)(0x01010101u * (127u - WIN_SHIFT)), scale_x = (int)(0x01010101u * (127u - XSHIFT));
    pg8_v8i At8[4], B08[2], B18[2];
    const char* cA = (const char*)g.A + (size_t)cur.pm * tstep; const char* cB = (const char*)g.Bt + (size_t)cur.pn * tstep;
    S.a_ready(cur);
    if constexpr (SP2) {
        PG8_STAGE(PG8_SB(0, 0), cB, voffB); PG8_STAGE(PG8_SB(0, 1), cB + hstep, voffB); PG8_STAGE(PG8_SA(0, 0), cA, voffA); PG8_STAGE(PG8_SA(0, 1), cA + hstep, voffA);
        if (wr == 1) PG8_BAR;
        PG8_WAIT_V(2); PG8_BAR;
        PG8_STAGE(PG8_SB(1, 0), cB + kstep, voffB); PG8_STAGE(PG8_SA(1, 0), cA + kstep, voffA); PG8_STAGE(PG8_SB(1, 1), cB + hstep + kstep, voffB);
        PG8_WAIT_V(6); PG8_BAR;
    } else {
        PG8_STAGE(PG8_SB(0, 0), cB, voffB); PG8_STAGE(PG8_SA(0, 0), cA, voffA); PG8_STAGE(PG8_SB(0, 1), cB + hstep, voffB); PG8_STAGE(PG8_SA(0, 1), cA + hstep, voffA);
        if (wr == 1) PG8_BAR;
        PG8_WAIT_V(4); PG8_BAR;
        PG8_STAGE(PG8_SB(1, 0), cB + kstep, voffB); PG8_STAGE(PG8_SA(1, 0), cA + kstep, voffA); PG8_STAGE(PG8_SB(1, 1), cB + hstep + kstep, voffB);
        PG8_WAIT_V(6); PG8_BAR;
    }
    for (;;) {
        const bool has_next = S.next(ui + 1, nxt);
        const char* nA = has_next ? (const char*)g.A + (size_t)nxt.pm * tstep : cA; const char* nB = has_next ? (const char*)g.Bt + (size_t)nxt.pn * tstep : cB;
        for (int t = 0; t < nt; t += 2) {
            const bool last = (t == nt - 2);
            const char* a1 = cA + (size_t)(t + 1) * kstep;
            const char* a2 = last ? nA : cA + (size_t)(t + 2) * kstep; const char* b2 = last ? nB : cB + (size_t)(t + 2) * kstep;
            const char* a3 = a2 + kstep; const char* b3 = b2 + kstep;
            if (last && has_next) S.a_ready(nxt);
            if constexpr (SP2) {
            PG8_LDB(B0, 0, 0); PG8_LDB(B1, 0, 1); PG8_SCHED; PG8_LDA(At, 0, 0); PG8_STAGE(PG8_SA(1, 1), a1 + hstep, voffA);
            PG8_WAIT_V(8); PG8_WAIT_L(0); PG8_BAR; PG8_MMA(0, 0, At, B0); PG8_MMA(0, 1, At, B1); PG8_BAR; PG8_SCHED;
            PG8_LDA(At, 0, 1); PG8_STAGE(PG8_SB(0, 0), b2, voffB); PG8_STAGE(PG8_SB(0, 1), b2 + hstep, voffB); PG8_STAGE(PG8_SA(0, 0), a2, voffA);
            PG8_WAIT_V(8); PG8_WAIT_L(0); PG8_BAR; PG8_MMA(1, 0, At, B0); PG8_MMA(1, 1, At, B1); PG8_BAR; PG8_SCHED;
            PG8_LDB(B0, 1, 0); PG8_LDB(B1, 1, 1); PG8_SCHED; PG8_LDA(At, 1, 0); PG8_STAGE(PG8_SA(0, 1), a2 + hstep, voffA);
            PG8_WAIT_V(8); PG8_WAIT_L(0); PG8_BAR; PG8_MMA(0, 0, At, B0); PG8_MMA(0, 1, At, B1); PG8_BAR; PG8_SCHED;
            PG8_LDA(At, 1, 1); PG8_STAGE(PG8_SB(1, 0), b3, voffB); PG8_STAGE(PG8_SB(1, 1), b3 + hstep, voffB); PG8_STAGE(PG8_SA(1, 0), a3, voffA);
            PG8_WAIT_V(8); PG8_WAIT_L(0); PG8_BAR; PG8_MMA(1, 0, At, B0); PG8_MMA(1, 1, At, B1); PG8_BAR; PG8_SCHED;
            } else {
            PG8_LDB(B0, 0, 0); PG8_SCHED; PG8_LDA(At, 0, 0); PG8_STAGE(PG8_SA(1, 1), a1 + hstep, voffA);
            PG8_WAIT_L(8); PG8_BAR; PG8_WAIT_L(0); PG8_MMA(0, 0, At, B0); PG8_BAR; PG8_SCHED;
            PG8_LDB(B1, 0, 1); PG8_STAGE(PG8_SB(0, 0), b2, voffB);
            PG8_BAR; PG8_WAIT_L(0); PG8_MMA(0, 1, At, B1); PG8_BAR;
            PG8_LDA(At, 0, 1); PG8_STAGE(PG8_SA(0, 0), a2, voffA);
            PG8_BAR; PG8_WAIT_L(0); PG8_MMA(1, 0, At, B0); PG8_BAR; PG8_SCHED;
            PG8_STAGE(PG8_SB(0, 1), b2 + hstep, voffB);
            PG8_WAIT_V(6); PG8_BAR; PG8_MMA(1, 1, At, B1); PG8_BAR;
            PG8_LDB(B0, 1, 0); PG8_SCHED; PG8_LDA(At, 1, 0); PG8_STAGE(PG8_SA(0, 1), a2 + hstep, voffA);
            PG8_WAIT_L(8); PG8_BAR; PG8_WAIT_L(0); PG8_MMA(0, 0, At, B0); PG8_BAR; PG8_SCHED;
            PG8_LDB(B1, 1, 1); PG8_STAGE(PG8_SB(1, 0), b3, voffB);
            PG8_BAR; PG8_WAIT_L(0); PG8_MMA(0, 1, At, B1); PG8_BAR;
            PG8_LDA(At, 1, 1); PG8_STAGE(PG8_SA(1, 0), a3, voffA);
            PG8_BAR; PG8_WAIT_L(0); PG8_MMA(1, 0, At, B0); PG8_BAR; PG8_SCHED;
            PG8_STAGE(PG8_SB(1, 1), b3 + hstep, voffB);
            PG8_WAIT_V(6); PG8_BAR; PG8_MMA(1, 1, At, B1); PG8_BAR;
            }
        }
        if constexpr (ALIGN_EPI) { if (wr == 0) PG8_BAR; }
        if constexpr (FP8) asm volatile("s_nop 15\n\ts_nop 15" ::: "memory");
        if constexpr (!Epi::AFTER_DRAIN) { E(acc, cur, wr, wc, fr, fq); S.done(cur); }
        if (!has_next) break;
#pragma unroll
        for (int a = 0; a < 2; ++a)
#pragma unroll
            for (int b = 0; b < 2; ++b)
#pragma unroll
                for (int m = 0; m < 4; ++m)
#pragma unroll
                    for (int n = 0; n < 2; ++n) acc[a][b][m][n] = (f32x4){0.f, 0.f, 0.f, 0.f};
        cur = nxt; cA = nA; cB = nB; ++ui;
        if constexpr (ALIGN_EPI) { if (wr == 1) PG8_BAR; }
    }
    PG8_WAIT_V(0);
    if constexpr (!ALIGN_EPI) { if (wr == 0) PG8_BAR; }
    PG8_BAR;
    if constexpr (Epi::AFTER_DRAIN) { E.fused(acc, cur, wr, wc, fr, fq, lds, wid, lane); S.done(cur); }
#undef PG8_SA
#undef PG8_SB
#undef PG8_STAGE
#undef PG8_LDA
#undef PG8_LDB
#undef PG8_MMA
#undef PG8_LD8
#undef PG8_WAIT_V
#undef PG8_WAIT_L
#undef PG8_BAR
#undef PG8_SCHED
}
template <class Epi, class Sched, bool ALIGN_EPI = false, bool SP2 = false, bool FP8 = false, int XSHIFT = 0>
__device__ __forceinline__ void gemm_phase(PG8_LAS unsigned char* lds, const Gemm g, const Sched& S, const Epi& E, const int tid) {
    f32x4 acc[2][2][4][2];
    gemm_phase_acc<Epi, Sched, ALIGN_EPI, SP2, FP8, true, XSHIFT>(lds, g, S, E, tid, acc);
}
struct OneUnit {
    Unit u;
    __device__ __forceinline__ bool next(int i, Unit& o) const { if (i != 0) return false; o = u; return true; }
    __device__ __forceinline__ void a_ready(const Unit&) const {}
    __device__ __forceinline__ void done(const Unit&) const {}
};
}

struct StaticOrderConv : pg8::StaticOrder {
    int tpm, tpn, t2pm, t2pn, row0, rstride, rowend, wit0; const float* w_in; const float* w_ba; const float* w_bb; const float* w_out; unsigned char* w_in8; unsigned char* w_ba8; unsigned char* w_bb8; unsigned char* w_out8; const float* eu; const float* ev; unsigned char* eu6; unsigned char* ev6; float* scl; const float* gain;
    __device__ __forceinline__ void pick() { const int nfull = nwg / G, nu = (nwg - 1 - c) / G + 1; const int r = nu <= nfull ? nu - 1 : (c >> 3) % nfull; pg8::Unit t; next(r, t); tpm = t.pm; tpn = t.pn;
        const int r2 = nu <= nfull ? nu - 1 : (r + 2) % nfull; next(r2, t); t2pm = t.pm; t2pn = t.pn; }
    __device__ __forceinline__ void done(const pg8::Unit& u) const {
        if (u.pm == tpm && u.pn == tpn) {
            unsigned z_ = 0u; asm volatile("" : "+v"(z_));
            Ctx cc; cc.gw = row0; cc.ngw = rstride; cc.lane = (int)__builtin_amdgcn_mbcnt_hi(~0u, __builtin_amdgcn_mbcnt_lo(~0u, z_)); asm volatile("" : "+v"(cc.lane));
            convert_fp6_rows_b4(eu, eu6, scl, row0, rstride, rowend, cc.lane, gain);
            asm volatile("s_waitcnt vmcnt(0)" ::: "memory");
        }
        if (wit0 >= 0 && u.pm == t2pm && u.pn == t2pn) {
            unsigned z_ = 0u; asm volatile("" : "+v"(z_));
            int ln = (int)__builtin_amdgcn_mbcnt_hi(~0u, __builtin_amdgcn_mbcnt_lo(~0u, z_)); asm volatile("" : "+v"(ln));
#pragma unroll 1
            for (int it = wit0; it < T64_LAYER; it += rstride) transpose_layer_item64(w_in, w_ba, w_bb, w_out, w_in8, w_ba8, w_bb8, w_out8, it, ln);
            asm volatile("s_waitcnt vmcnt(0)" ::: "memory");
        }
    }
};
constexpr int EX_OFF = MISC_OFF + 1024;
__device__ __forceinline__ float fast_sigmoid(float z) { return __builtin_amdgcn_rcpf(1.0f + __builtin_amdgcn_exp2f(-z * LOG2E)); }
__device__ __forceinline__ float rows_sum4(float v) {
    auto a = __builtin_amdgcn_permlane16_swap(__float_as_uint(v), __float_as_uint(v), false, false); v = __uint_as_float(a[0]) + __uint_as_float(a[1]);
    auto b = __builtin_amdgcn_permlane32_swap(__float_as_uint(v), __float_as_uint(v), false, false); return __uint_as_float(b[0]) + __uint_as_float(b[1]);
}
__device__ __forceinline__ int cls_row(int s) { return ((s & 15) << 7) | (s >> 4); }
__device__ __forceinline__ int cls_pos(int r) { return ((r & 127) << 4) | (r >> 7); }
struct EpiProjFused {
    static constexpr bool PERM = true, AFTER_DRAIN = false;
    bf16_t* Qo; bf16_t* Ko; bf16_t* Vo; bf16_t* gate; const float* qn; const float* kn; const float* rot; LAS unsigned char* lds; const float* bg;
    __device__ __forceinline__ void operator()(const pg8::f32x4 (&acc)[2][2][4][2], const pg8::Unit& u, int wr, int wc, int fr, int fq) const {
        const int row0 = u.pm * 256 + wr * 64 + fr;
        if (u.pn >= QKV_COLS / 256) {
            const int col0 = (u.pn - QKV_COLS / 256) * 256 + wc * 32 + 8 * fq;
            pg8::f32x4 bia[2][2];
#pragma unroll
            for (int bj = 0; bj < 2; ++bj) { bia[bj][0] = *(const pg8::f32x4*)(bg + col0 + bj * 128); bia[bj][1] = *(const pg8::f32x4*)(bg + col0 + bj * 128 + 4); }
            const int colw = col0 - 8 * (fq & 1);
#pragma unroll
            for (int ai = 0; ai < 2; ++ai)
#pragma unroll
                for (int m = 0; m < 4; m += 2) { unsigned char* rowp = (unsigned char*)gate + (size_t)(row0 + ai * 128 + (m + (fq & 1)) * 16) * (2 * DM) + colw;
#pragma unroll
                    for (int bj = 0; bj < 2; ++bj) { constexpr float GS = (float)(1 << GATE_SHIFT); unsigned pk[2][2];
#pragma unroll
                        for (int mm = 0; mm < 2; ++mm) { const pg8::f32x4 v0 = (acc[ai][bj][m + mm][0] + bia[bj][0]) * GS, v1 = (acc[ai][bj][m + mm][1] + bia[bj][1]) * GS;
                            int w0 = __builtin_amdgcn_cvt_pk_fp8_f32(v0[0], v0[1], 0, false); w0 = __builtin_amdgcn_cvt_pk_fp8_f32(v0[2], v0[3], w0, true);
                            int w1 = __builtin_amdgcn_cvt_pk_fp8_f32(v1[0], v1[1], 0, false); w1 = __builtin_amdgcn_cvt_pk_fp8_f32(v1[2], v1[3], w1, true);
                            pk[mm][0] = (unsigned)w0; pk[mm][1] = (unsigned)w1; }
                        const auto s0 = __builtin_amdgcn_permlane16_swap(pk[0][0], pk[1][0], false, false), s1 = __builtin_amdgcn_permlane16_swap(pk[0][1], pk[1][1], false, false);
                        *(v4u*)(rowp + bj * 128) = (v4u){s0[0], s1[0], s0[1], s1[1]}; } }
            return;
        }
        const int sel = u.pn / 10, hp = 2 * (u.pn % 10), qd = 4 * wc + fq;
        const bool cls = hp >= 8 && hp < DIL_HEADS;
        if (sel == 2) {
#pragma unroll
            for (int ai = 0; ai < 2; ++ai)
#pragma unroll
                for (int m = 0; m < 4; m += 2) { const int row = row0 + ai * 128 + (m + (fq & 1)) * 16, b = row >> 11, sq0 = row & (SEQ - 1), sq = cls ? cls_row(sq0) : sq0;
#pragma unroll
                    for (int bj = 0; bj < 2; ++bj) { unsigned pk[2][2];
#pragma unroll
                        for (int mm = 0; mm < 2; ++mm) { const pg8::f32x4 v0 = acc[ai][bj][m + mm][0], v1 = acc[ai][bj][m + mm][1];
                            int w0 = __builtin_amdgcn_cvt_pk_fp8_f32(v0[0], v0[1], 0, false); w0 = __builtin_amdgcn_cvt_pk_fp8_f32(v0[2], v0[3], w0, true);
                            int w1 = __builtin_amdgcn_cvt_pk_fp8_f32(v1[0], v1[1], 0, false); w1 = __builtin_amdgcn_cvt_pk_fp8_f32(v1[2], v1[3], w1, true);
                            pk[mm][0] = (unsigned)w0; pk[mm][1] = (unsigned)w1; }
                        const auto s0 = __builtin_amdgcn_permlane16_swap(pk[0][0], pk[1][0], false, false), s1 = __builtin_amdgcn_permlane16_swap(pk[0][1], pk[1][1], false, false);
                        *(v4u*)((unsigned char*)Vo + (((size_t)b * NHEADS + hp + bj) * SEQ + sq) * HD + 8 * (qd - (fq & 1))) = (v4u){s0[0], s1[0], s0[1], s1[1]}; } }
            return;
        }
        LAS float* ex = (LAS float*)(lds + EX_OFF);
        const float* gn = sel == 0 ? qn : kn; bf16_t* dst = sel == 0 ? Qo : Ko; const float osc = sel == 0 ? QSCALE : 1.0f;
        const bool dil = hp < DIL_HEADS;
        pg8::f32x4 g1[2], g2[2], cs[2][4], sn[2][4];
#pragma unroll
        for (int bj = 0; bj < 2; ++bj) { g1[bj] = *(const pg8::f32x4*)(gn + (hp + bj) * HD + 4 * qd); g2[bj] = *(const pg8::f32x4*)(gn + (hp + bj) * HD + 64 + 4 * qd); }
        const float* rotp = rot + (size_t)((u.pm * 256 + wr * 64 + fr) & (SEQ - 1)) * 64 + 4 * qd;
#define EPF_ROT(k_) do { cs[(k_) >> 2][(k_) & 3] = *(const pg8::f32x4*)(rotp + (((k_) >> 2) * 128 + ((k_) & 3) * 16) * 64); sn[(k_) >> 2][(k_) & 3] = *(const pg8::f32x4*)(rotp + SEQ * 64 + (((k_) >> 2) * 128 + ((k_) & 3) * 16) * 64); } while (0)
        if (dil) { EPF_ROT(0); EPF_ROT(1); EPF_ROT(2); }
        asm volatile("" ::: "memory");
#pragma unroll
        for (int ai = 0; ai < 2; ++ai)
#pragma unroll
            for (int m = 0; m < 4; ++m)
#pragma unroll
                for (int bj = 0; bj < 2; ++bj) { const pg8::f32x4 v0 = acc[ai][bj][m][0], v1 = acc[ai][bj][m][1];
                    float ss = (v0[0] * v0[0] + v0[1] * v0[1]) + (v0[2] * v0[2] + v0[3] * v0[3]) + (v1[0] * v1[0] + v1[1] * v1[1]) + (v1[2] * v1[2] + v1[3] * v1[3]);
                    ss = rows_sum4(ss);
                    if (fq == 0) ex[((ai * 128 + wr * 64 + m * 16 + fr) * 2 + bj) * 4 + wc] = ss; }
        asm volatile("s_waitcnt lgkmcnt(0)" ::: "memory"); __builtin_amdgcn_s_barrier(); asm volatile("" ::: "memory");
#pragma unroll
        for (int ai = 0; ai < 2; ++ai)
#pragma unroll
            for (int m = 0; m < 4; m += 2) {
                unsigned P1[2][2][2], P2[2][2][2];
#pragma unroll
                for (int mm = 0; mm < 2; ++mm) { const int mq = m + mm, rl = ai * 128 + wr * 64 + mq * 16 + fr;
                    asm volatile("" ::: "memory");
                    if (ai * 4 + mq + 3 < 8 && dil) { EPF_ROT(ai * 4 + mq + 3); asm volatile("" ::: "memory"); }
#pragma unroll
                    for (int bj = 0; bj < 2; ++bj) {
                        const pg8::f32x4 e = *(const LAS pg8::f32x4*)(ex + (rl * 2 + bj) * 4);
                        const float rstd = osc * __builtin_amdgcn_rsqf(((e[0] + e[1]) + (e[2] + e[3])) * (1.0f / HD) + RMS_EPS);
                        pg8::f32x4 y1 = acc[ai][bj][mq][0] * rstd * g1[bj], y2 = acc[ai][bj][mq][1] * rstd * g2[bj];
                        if (dil) { const pg8::f32x4 o1 = y1 * cs[ai][mq] - y2 * sn[ai][mq], o2 = y2 * cs[ai][mq] + y1 * sn[ai][mq]; y1 = o1; y2 = o2; }
                        if (sel == 0) { P1[mm][bj][0] = pg8::cvt_pk_bf16(y1[0], y1[1]); P1[mm][bj][1] = pg8::cvt_pk_bf16(y1[2], y1[3]); P2[mm][bj][0] = pg8::cvt_pk_bf16(y2[0], y2[1]); P2[mm][bj][1] = pg8::cvt_pk_bf16(y2[2], y2[3]); }
                        else { int p1 = __builtin_amdgcn_cvt_pk_fp8_f32(y1[0], y1[1], 0, false); p1 = __builtin_amdgcn_cvt_pk_fp8_f32(y1[2], y1[3], p1, true);
                               int p2 = __builtin_amdgcn_cvt_pk_fp8_f32(y2[0], y2[1], 0, false); p2 = __builtin_amdgcn_cvt_pk_fp8_f32(y2[2], y2[3], p2, true);
                               P1[mm][bj][0] = (unsigned)p1; P2[mm][bj][0] = (unsigned)p2; P1[mm][bj][1] = 0u; P2[mm][bj][1] = 0u; } } }
                const int rowe = u.pm * 256 + ai * 128 + wr * 64 + (m + (fq & 1)) * 16 + fr, b = rowe >> 11, sq = rowe & (SEQ - 1);
#pragma unroll
                for (int bj = 0; bj < 2; ++bj) { const int head = hp + bj;
                    const size_t eo = (((size_t)b * NHEADS + head) * SEQ + (cls ? cls_row(sq) : sq)) * HD + 4 * (qd - (fq & 1));
                    if (sel == 0) { bf16_t* rp = dst + eo;
                        const auto a0 = __builtin_amdgcn_permlane16_swap(P1[0][bj][0], P1[1][bj][0], false, false), a1 = __builtin_amdgcn_permlane16_swap(P1[0][bj][1], P1[1][bj][1], false, false);
                        const auto c0 = __builtin_amdgcn_permlane16_swap(P2[0][bj][0], P2[1][bj][0], false, false), c1 = __builtin_amdgcn_permlane16_swap(P2[0][bj][1], P2[1][bj][1], false, false);
                        *(v4u*)rp = (v4u){a0[0], a1[0], a0[1], a1[1]}; *(v4u*)(rp + 64) = (v4u){c0[0], c1[0], c0[1], c1[1]}; }
                    else { unsigned char* rp = (unsigned char*)dst + eo;
                        const auto a0 = __builtin_amdgcn_permlane16_swap(P1[0][bj][0], P1[1][bj][0], false, false), c0 = __builtin_amdgcn_permlane16_swap(P2[0][bj][0], P2[1][bj][0], false, false);
                        *(v2u*)rp = (v2u){a0[0], a0[1]}; *(v2u*)(rp + 64) = (v2u){c0[0], c0[1]}; } } }
#undef EPF_ROT
    }
};
struct EpiBf16F {
    static constexpr bool PERM = true, AFTER_DRAIN = false;
    bf16_t* O; int ldc;
    __device__ __forceinline__ void operator()(const pg8::f32x4 (&acc)[2][2][4][2], const pg8::Unit& u, int wr, int wc, int fr, int fq) const {
        const int row0 = u.pm * 256 + wr * 64 + fr, col0 = u.pn * 256 + wc * 32 + 8 * fq;
#pragma unroll
        for (int ai = 0; ai < 2; ++ai)
#pragma unroll
            for (int m = 0; m < 4; ++m) { bf16_t* rowp = O + (size_t)(row0 + ai * 128 + m * 16) * ldc + col0;
#pragma unroll
                for (int bj = 0; bj < 2; ++bj) { const pg8::f32x4 v0 = acc[ai][bj][m][0], v1 = acc[ai][bj][m][1];
                    pg8::u32x4 w; w.x = pg8::cvt_pk_bf16(v0[0], v0[1]); w.y = pg8::cvt_pk_bf16(v0[2], v0[3]); w.z = pg8::cvt_pk_bf16(v1[0], v1[1]); w.w = pg8::cvt_pk_bf16(v1[2], v1[3]);
                    *(pg8::u32x4*)(rowp + bj * 128) = w; } }
    }
};
__device__ __forceinline__ float sig_den(float z) { return 1.0f + __builtin_amdgcn_exp2f(fminf(-z * LOG2E, 64.0f)); }
struct EpiBranchScale {
    static constexpr bool PERM = true, AFTER_DRAIN = false;
    const bf16_t* gate;
    __device__ __forceinline__ void operator()(pg8::f32x4 (&acc)[2][2][4][2], const pg8::Unit& u, int wr, int wc, int fr, int fq) const {
        constexpr float GI = 1.0f / (float)(1 << GATE_SHIFT);
        const unsigned char* gp = (const unsigned char*)gate + (size_t)(u.pm * 256 + wr * 64 + fr) * (2 * DM) + (u.pn * 256 + wc * 32 + 8 * fq);
#pragma unroll
        for (int ai = 0; ai < 2; ++ai)
#pragma unroll
            for (int m = 0; m < 4; ++m) {
                const unsigned char* ga_p = gp + (size_t)(ai * 128 + m * 16) * (2 * DM); const unsigned char* gb_p = ga_p + DM;
                asm volatile("" : "+v"(ga_p), "+v"(gb_p) :: "memory");
#pragma unroll
                for (int bj = 0; bj < 2; ++bj) {
                    asm volatile("" ::: "memory");
                    const v2u ga = *(const v2u*)(ga_p + bj * 128), gb = *(const v2u*)(gb_p + bj * 128);
                    const auto a0 = __builtin_amdgcn_cvt_pk_f32_fp8((int)ga.x, false), a1 = __builtin_amdgcn_cvt_pk_f32_fp8((int)ga.x, true), a2 = __builtin_amdgcn_cvt_pk_f32_fp8((int)ga.y, false), a3 = __builtin_amdgcn_cvt_pk_f32_fp8((int)ga.y, true);
                    const auto b0 = __builtin_amdgcn_cvt_pk_f32_fp8((int)gb.x, false), b1 = __builtin_amdgcn_cvt_pk_f32_fp8((int)gb.x, true), b2 = __builtin_amdgcn_cvt_pk_f32_fp8((int)gb.y, false), b3 = __builtin_amdgcn_cvt_pk_f32_fp8((int)gb.y, true);
#define EBS_R(ga_, gb_) (sig_den((gb_) * GI) * fast_sigmoid((ga_) * GI))
                    acc[ai][bj][m][0][0] *= EBS_R(a0[0], b0[0]); acc[ai][bj][m][0][1] *= EBS_R(a0[1], b0[1]);
                    acc[ai][bj][m][0][2] *= EBS_R(a1[0], b1[0]); acc[ai][bj][m][0][3] *= EBS_R(a1[1], b1[1]);
                    acc[ai][bj][m][1][0] *= EBS_R(a2[0], b2[0]); acc[ai][bj][m][1][1] *= EBS_R(a2[1], b2[1]);
                    acc[ai][bj][m][1][2] *= EBS_R(a3[0], b3[0]); acc[ai][bj][m][1][3] *= EBS_R(a3[1], b3[1]);
#undef EBS_R
                    asm volatile("" : "+v"(acc[ai][bj][m][0]), "+v"(acc[ai][bj][m][1]));
                } }
    }
};
struct EpiBranchOut {
    static constexpr bool PERM = true, AFTER_DRAIN = false;
    bf16_t* merged; const bf16_t* gate;
    __device__ __forceinline__ void operator()(const pg8::f32x4 (&acc)[2][2][4][2], const pg8::Unit& u, int wr, int wc, int fr, int fq) const {
        const int row0 = u.pm * 256 + wr * 64 + fr, col0 = u.pn * 256 + wc * 32 + 8 * fq;
#pragma unroll
        for (int ai = 0; ai < 2; ++ai)
#pragma unroll
            for (int m = 0; m < 4; ++m) { const size_t row = (size_t)(row0 + ai * 128 + m * 16);
#pragma unroll
                for (int bj = 0; bj < 2; ++bj) { const int c = col0 + bj * 128;
                    asm volatile("" ::: "memory");
                    const v2u gl = *(const v2u*)((const unsigned char*)gate + row * (2 * DM) + c);
                    const auto g0 = __builtin_amdgcn_cvt_pk_f32_fp8((int)gl.x, false), g1 = __builtin_amdgcn_cvt_pk_f32_fp8((int)gl.x, true), g2 = __builtin_amdgcn_cvt_pk_f32_fp8((int)gl.y, false), g3 = __builtin_amdgcn_cvt_pk_f32_fp8((int)gl.y, true);
                    constexpr float GI = 1.0f / (float)(1 << GATE_SHIFT);
#define EBO_S(g_) __builtin_amdgcn_rcpf(sig_den((g_) * GI))
                    pg8::f32x4 o0, o1;
                    o0[0] = EBO_S(g0[0]) * acc[ai][bj][m][0][0]; o0[1] = EBO_S(g0[1]) * acc[ai][bj][m][0][1];
                    o0[2] = EBO_S(g1[0]) * acc[ai][bj][m][0][2]; o0[3] = EBO_S(g1[1]) * acc[ai][bj][m][0][3];
                    o1[0] = EBO_S(g2[0]) * acc[ai][bj][m][1][0]; o1[1] = EBO_S(g2[1]) * acc[ai][bj][m][1][1];
                    o1[2] = EBO_S(g3[0]) * acc[ai][bj][m][1][2]; o1[3] = EBO_S(g3[1]) * acc[ai][bj][m][1][3];
#undef EBO_S
                    constexpr float MS = (float)(1 << MRG_SHIFT);
                    int w0 = __builtin_amdgcn_cvt_pk_fp8_f32(o0[0] * MS, o0[1] * MS, 0, false); w0 = __builtin_amdgcn_cvt_pk_fp8_f32(o0[2] * MS, o0[3] * MS, w0, true);
                    int w1 = __builtin_amdgcn_cvt_pk_fp8_f32(o1[0] * MS, o1[1] * MS, 0, false); w1 = __builtin_amdgcn_cvt_pk_fp8_f32(o1[2] * MS, o1[3] * MS, w1, true);
                    *(v2u*)((unsigned char*)merged + row * DM + c) = (v2u){(unsigned)w0, (unsigned)w1}; } }
    }
};
template <bool XB16>
struct EpiResidualNorm {
    static constexpr bool PERM = true, AFTER_DRAIN = false;
    const float* xin; bf16_t* xb; float* partss; LAS unsigned char* lds; unsigned char* x8;
    __device__ __forceinline__ void operator()(const pg8::f32x4 (&acc)[2][2][4][2], const pg8::Unit& u, int wr, int wc, int fr, int fq) const {
        const int row0 = u.pm * 256 + wr * 64 + fr, col0 = u.pn * 256 + wc * 32 + 8 * fq;
        LAS float* ex = (LAS float*)(lds + EX_OFF);
#pragma unroll
        for (int ai = 0; ai < 2; ++ai)
#pragma unroll
            for (int m = 0; m < 4; ++m) { const size_t o = (size_t)(row0 + ai * 128 + m * 16) * DM + col0; float ss = 0.f;
#pragma unroll
                for (int bj = 0; bj < 2; ++bj) {
                    asm volatile("" ::: "memory");
                    pg8::f32x4 a, b;
                    if (XB16) { const pg8::u32x4 w_ = *(const pg8::u32x4*)((const bf16_t*)xin + o + bj * 128); a = (pg8::f32x4){bflo(w_.x), bfhi(w_.x), bflo(w_.y), bfhi(w_.y)}; b = (pg8::f32x4){bflo(w_.z), bfhi(w_.z), bflo(w_.w), bfhi(w_.w)}; }
                    else { a = *(const pg8::f32x4*)(xin + o + bj * 128); b = *(const pg8::f32x4*)(xin + o + bj * 128 + 4); }
                    const pg8::f32x4 x0 = a + acc[ai][bj][m][0], x1v = b + acc[ai][bj][m][1];
                    ss += (x0[0] * x0[0] + x0[1] * x0[1]) + (x0[2] * x0[2] + x0[3] * x0[3]) + (x1v[0] * x1v[0] + x1v[1] * x1v[1]) + (x1v[2] * x1v[2] + x1v[3] * x1v[3]);
                    pg8::u32x4 w; w.x = pg8::cvt_pk_bf16(x0[0], x0[1]); w.y = pg8::cvt_pk_bf16(x0[2], x0[3]); w.z = pg8::cvt_pk_bf16(x1v[0], x1v[1]); w.w = pg8::cvt_pk_bf16(x1v[2], x1v[3]);
                    *(pg8::u32x4*)(xb + o + bj * 128) = w;
                    { constexpr float XS = (float)(1 << X1_SHIFT);
                      int w0 = __builtin_amdgcn_cvt_pk_fp8_f32(x0[0] * XS, x0[1] * XS, 0, false); w0 = __builtin_amdgcn_cvt_pk_fp8_f32(x0[2] * XS, x0[3] * XS, w0, true);
                      int w1 = __builtin_amdgcn_cvt_pk_fp8_f32(x1v[0] * XS, x1v[1] * XS, 0, false); w1 = __builtin_amdgcn_cvt_pk_fp8_f32(x1v[2] * XS, x1v[3] * XS, w1, true);
                      *(v2u*)(x8 + o + bj * 128) = (v2u){(unsigned)w0, (unsigned)w1}; }
 }
                ss = rows_sum4(ss);
                if (fq == 0) ex[(ai * 128 + wr * 64 + m * 16 + fr) * 4 + wc] = ss; }
        asm volatile("s_waitcnt lgkmcnt(0)" ::: "memory"); __builtin_amdgcn_s_barrier(); asm volatile("" ::: "memory");
        if (wc == 0 && fq == 0) {
#pragma unroll
            for (int ai = 0; ai < 2; ++ai)
#pragma unroll
                for (int m = 0; m < 4; ++m) { const int rl = ai * 128 + wr * 64 + m * 16 + fr; const pg8::f32x4 e = *(const LAS pg8::f32x4*)(ex + rl * 4);
                    partss[(size_t)(u.pm * 256 + rl) * 8 + u.pn] = (e[0] + e[1]) + (e[2] + e[3]); }
        }
    }
};
__device__ __forceinline__ float row_rstd(const float* partss, int row) {
    const f32x4 a = *(const f32x4*)(partss + (size_t)row * 8), b = *(const f32x4*)(partss + (size_t)row * 8 + 4);
    return __builtin_amdgcn_rsqf((((a.x + a.y) + (a.z + a.w)) + ((b.x + b.y) + (b.z + b.w))) * (1.0f / DM) + RMS_EPS);
}
struct EpiBf16RowScale {
    static constexpr bool PERM = true, AFTER_DRAIN = false;
    bf16_t* O; int ldc; const float* partss;
    __device__ __forceinline__ void operator()(const pg8::f32x4 (&acc)[2][2][4][2], const pg8::Unit& u, int wr, int wc, int fr, int fq) const {
        const int row0 = u.pm * 256 + wr * 64 + fr, col0 = u.pn * 256 + wc * 32 + 8 * fq;
#pragma unroll
        for (int ai = 0; ai < 2; ++ai)
#pragma unroll
            for (int m = 0; m < 4; ++m) { const int row = row0 + ai * 128 + m * 16; const float rs = row_rstd(partss, row); bf16_t* rowp = O + (size_t)row * ldc + col0;
#pragma unroll
                for (int bj = 0; bj < 2; ++bj) { const pg8::f32x4 v0 = acc[ai][bj][m][0], v1 = acc[ai][bj][m][1];
                    pg8::u32x4 w; w.x = pg8::cvt_pk_bf16(v0[0] * rs, v0[1] * rs); w.y = pg8::cvt_pk_bf16(v0[2] * rs, v0[3] * rs); w.z = pg8::cvt_pk_bf16(v1[0] * rs, v1[1] * rs); w.w = pg8::cvt_pk_bf16(v1[2] * rs, v1[3] * rs);
                    *(pg8::u32x4*)(rowp + bj * 128) = w; } }
    }
};

__device__ __forceinline__ void decay_cumsum(const float* logf, float* kbias, float* zbias, const Ctx& c) {
    const int gwr = c.ngw - 1 - c.gw;
    if (blockIdx.x == gridDim.x - 1) for (int i = c.tid; i < SEQ; i += NTHREADS) zbias[i] = 0.f;
    if (gwr < NBATCH * FOX_HEADS) {
        const int b = gwr / FOX_HEADS, h = gwr % FOX_HEADS;
        float loc[32]; float run = 0.f;
#pragma unroll
        for (int i = 0; i < 32; ++i) { run += logf[((size_t)b * SEQ + c.lane * 32 + i) * 8 + h]; loc[i] = run; }
        float incl = run;
#pragma unroll
        for (int o = 1; o < 64; o <<= 1) { const float t = __shfl_up(incl, o); if (c.lane >= o) incl += t; }
        const float excl = incl - run;
#pragma unroll
        for (int i = 0; i < 32; ++i) kbias[((size_t)b * FOX_HEADS + h) * SEQ + c.lane * 32 + i] = -(excl + loc[i]) * LOG2E;
    }
}
__device__ __forceinline__ void phase_prep(const bf16_t* proj, const float* qn_l, const float* kn_l, bf16_t* Qo, bf16_t* Ko, bf16_t* Vo, const float* logf, float* kbias, float* zbias, const Ctx& c) {
    if (blockIdx.x == 0) for (int i = c.tid; i < SEQ; i += NTHREADS) zbias[i] = 0.f;
    const float inv_freq = exp2f(-(float)c.lane * (13.287712379549449f / 64.0f));
    for (int it = c.gw; it < T * NHEADS; it += c.ngw) {
        const int row = it / NHEADS, h = it - row * NHEADS, b = row / SEQ, s = row - b * SEQ;
        const bf16_t* pr = proj + (size_t)row * QKV_COLS + h * HD;
        float q1 = bf2f(pr[c.lane]), q2 = bf2f(pr[c.lane + 64]);
        float k1 = bf2f(pr[NHEADS * HD + c.lane]), k2 = bf2f(pr[NHEADS * HD + c.lane + 64]);
        const bf16_t v1 = pr[2 * NHEADS * HD + c.lane], v2 = pr[2 * NHEADS * HD + c.lane + 64];
        const float qr = 1.0f / sqrtf(wave_sum(q1 * q1 + q2 * q2) * (1.0f / HD) + RMS_EPS);
        const float kr = 1.0f / sqrtf(wave_sum(k1 * k1 + k2 * k2) * (1.0f / HD) + RMS_EPS);
        q1 *= qr * qn_l[h * HD + c.lane]; q2 *= qr * qn_l[h * HD + c.lane + 64];
        k1 *= kr * kn_l[h * HD + c.lane]; k2 *= kr * kn_l[h * HD + c.lane + 64];
        if (h < DIL_HEADS) {
            float sn, cs; sincosf((float)s * inv_freq, &sn, &cs);
            const float a = q1 * cs - q2 * sn, bq = q2 * cs + q1 * sn; q1 = a; q2 = bq;
            const float ck = k1 * cs - k2 * sn, dk = k2 * cs + k1 * sn; k1 = ck; k2 = dk;
        }
        const size_t o = (((size_t)b * NHEADS + h) * SEQ + s) * HD;
        Qo[o + c.lane] = (bf16_t)f2bf(q1 * QSCALE); Qo[o + c.lane + 64] = (bf16_t)f2bf(q2 * QSCALE);
        Ko[o + c.lane] = (bf16_t)f2bf(k1); Ko[o + c.lane + 64] = (bf16_t)f2bf(k2);
        Vo[o + c.lane] = v1; Vo[o + c.lane + 64] = v2;
    }
    if (c.gw < NBATCH * FOX_HEADS) {
        const int b = c.gw / FOX_HEADS, h = c.gw % FOX_HEADS;
        float loc[32]; float run = 0.f;
#pragma unroll
        for (int i = 0; i < 32; ++i) { run += logf[((size_t)b * SEQ + c.lane * 32 + i) * 8 + h]; loc[i] = run; }
        float incl = run;
#pragma unroll
        for (int o = 1; o < 64; o <<= 1) { const float t = __shfl_up(incl, o); if (c.lane >= o) incl += t; }
        const float excl = incl - run;
#pragma unroll
        for (int i = 0; i < 32; ++i) kbias[((size_t)b * FOX_HEADS + h) * SEQ + c.lane * 32 + i] = -(excl + loc[i]) * LOG2E;
    }
}

__device__ __forceinline__ void attn_step(float sc, unsigned vw, float& m, float& l, float& o0, float& o1) {
    const float mn = fmaxf(m, sc), al = exp2f(m - mn), p = exp2f(sc - mn);
    l = l * al + p; o0 = o0 * al + p * bflo(vw); o1 = o1 * al + p * bfhi(vw); m = mn;
}
__device__ __forceinline__ void phase_attn_naive(const bf16_t* Q, const bf16_t* K, const bf16_t* V, const float* kbias, bf16_t* oa, bf16_t* ob, const Ctx& c) {
    constexpr int NA = NBATCH * 4 * SEQ, NBI = NBATCH * FOX_HEADS * SEQ;
    for (int it = c.gw; it < NA + NBI; it += c.ngw) {
        float m = -1e30f, l = 0.f, o0 = 0.f, o1 = 0.f;
        if (it < NA) {
            const int b = it / (4 * SEQ), r = it - b * 4 * SEQ, slot = r / SEQ, t = r - slot * SEQ;
#pragma unroll 1
            for (int g = 0; g < 3; ++g) {
                const int dil = g == 0 ? 1 : g == 1 ? 4 : 16, head = g * 4 + slot;
                const size_t hb = ((size_t)b * NHEADS + head) * SEQ;
                const unsigned qw = ((const unsigned*)(Q + (hb + t) * HD))[c.lane];
                for (int j = 0; j <= 128; ++j) {
                    const int s = t - j * dil; if (s < 0) break;
                    const unsigned kw = ((const unsigned*)(K + (hb + s) * HD))[c.lane];
                    const unsigned vw = ((const unsigned*)(V + (hb + s) * HD))[c.lane];
                    const float sc = wave_sum(dot2(qw, kw, 0.f));
                    attn_step(sc, vw, m, l, o0, o1);
                }
            }
            const float il = 1.0f / l;
            ((unsigned*)(oa + ((size_t)b * SEQ + t) * A_OUT + slot * HD))[c.lane] = pk2(o0 * il, o1 * il);
        } else {
            const int i2 = it - NA, b = i2 / (FOX_HEADS * SEQ), r = i2 - b * FOX_HEADS * SEQ, h = r / SEQ, t = r - h * SEQ;
            const size_t hb = ((size_t)b * NHEADS + DIL_HEADS + h) * SEQ;
            const float* kb = kbias + ((size_t)b * FOX_HEADS + h) * SEQ;
            const unsigned qw = ((const unsigned*)(Q + (hb + t) * HD))[c.lane];
            for (int s = 0; s <= t; ++s) {
                const unsigned kw = ((const unsigned*)(K + (hb + s) * HD))[c.lane];
                const unsigned vw = ((const unsigned*)(V + (hb + s) * HD))[c.lane];
                const float sc = wave_sum(dot2(qw, kw, 0.f)) + kb[s];
                attn_step(sc, vw, m, l, o0, o1);
            }
            const float il = 1.0f / l;
            ((unsigned*)(ob + ((size_t)b * SEQ + t) * B_OUT + h * HD))[c.lane] = pk2(o0 * il, o1 * il);
        }
    }
}

namespace att {
constexpr int D = 128, NW = 8, QBLK = 32, KVBLK = 64, QB = NW * QBLK;
constexpr int SHM_V = KVBLK * D * 2, SHM_K = KVBLK * D * 2;
constexpr int OFF_WS = 2 * SHM_V + 2 * SHM_K, OFF_BIAS = OFF_WS + NW * 64 * 4, LDS_BYTES_ATT = OFF_BIAS + 2 * KVBLK * 4;
constexpr float THR2 = 8.f * 1.4426950408889634f;
typedef unsigned short bf16;
typedef short bf16x8 __attribute__((ext_vector_type(8)));
typedef short s16x4 __attribute__((ext_vector_type(4)));
typedef float f32x16 __attribute__((ext_vector_type(16)));
typedef float f32x4 __attribute__((ext_vector_type(4)));
typedef unsigned u32x4 __attribute__((ext_vector_type(4)));
#define KSWZ(row, colB) ((row) * 256 + ((colB) ^ (((row) & 7) << 4)))
#define SBAR() __builtin_amdgcn_sched_barrier(0)
__device__ __forceinline__ int v_st(int k, int c) { const int kk = (k & ~0xC) | ((k & 4) << 1) | ((k & 8) >> 1); return ((kk >> 3) * 4 + (c >> 5)) * 512 + ((kk & 7) * 32 + (c & 31)) * 2; }
__device__ __forceinline__ int v_rd_base(int lane) { return ((lane & 3) << 3) | (((lane >> 2) & 3) << 6) | (((lane >> 4) & 1) << 5) | (((lane >> 5) & 1) << 8); }
constexpr int v_rd_off(int d0, int ks, int half) { return d0 * 512 + ks * 4096 + half * 2048; }
__device__ __forceinline__ int crow(int r, int hi) { return (r & 3) + 8 * (r >> 2) + 4 * hi; }
__device__ __forceinline__ unsigned cvtpk(float lo, float hi) { unsigned r; asm volatile("v_cvt_pk_bf16_f32 %0, %1, %2" : "=v"(r) : "v"(lo), "v"(hi)); return r; }
__device__ __forceinline__ bf16x8 load8(const bf16* p) { return *reinterpret_cast<const bf16x8*>(p); }
template <bool DIL>
__device__ __forceinline__ void mask_tile(f32x16& p0, f32x16& p1, int dq, unsigned W, int dmask) {
    const float NEG = -__builtin_inff();
#pragma unroll
    for (int r = 0; r < 16; ++r) {
        const int c = (r & 3) + 8 * (r >> 2);
        const int d0 = dq - c, d1 = dq - c - 32;
        if ((unsigned)d0 >= W || (DIL && (d0 & dmask))) p0[r] = NEG;
        if ((unsigned)d1 >= W || (DIL && (d1 & dmask))) p1[r] = NEG;
    }
}
__device__ __forceinline__ void partialSM(f32x16& p0, f32x16& p1, float& m_reg, float& mn, float& alpha) {
    float pmax = p0[0]; for (int r = 1; r < 16; ++r) pmax = fmaxf(pmax, p0[r]); for (int r = 0; r < 16; ++r) pmax = fmaxf(pmax, p1[r]);
    { auto rr = __builtin_amdgcn_permlane32_swap(__float_as_uint(pmax), __float_as_uint(pmax), false, false);
      pmax = fmaxf(__uint_as_float(rr[0]), __uint_as_float(rr[1])); }
    if (__builtin_expect(__all((pmax - m_reg) <= THR2), 1)) { mn = m_reg; alpha = 1.f; }
    else { mn = fmaxf(m_reg, pmax); alpha = __builtin_amdgcn_exp2f(m_reg - mn); m_reg = mn; }
    for (int r = 0; r < 16; ++r) p0[r] = p0[r] - mn; for (int r = 0; r < 16; ++r) p1[r] = p1[r] - mn;
    for (int r = 0; r < 16; ++r) p0[r] = __builtin_amdgcn_exp2f(p0[r]);
}
__device__ __forceinline__ void finishSM(f32x16& p0, f32x16& p1, float alpha, float& l_reg, bf16x8& pa0, bf16x8& pa1, bf16x8& pa2, bf16x8& pa3) {
    for (int r = 0; r < 16; ++r) p1[r] = __builtin_amdgcn_exp2f(p1[r]);
    float ps = 0; for (int r = 0; r < 16; ++r) ps += p0[r]; for (int r = 0; r < 16; ++r) ps += p1[r];
    { auto rr = __builtin_amdgcn_permlane32_swap(__float_as_uint(ps), __float_as_uint(ps), false, false);
      ps = __uint_as_float(rr[0]) + __uint_as_float(rr[1]); }
    l_reg = l_reg * alpha + ps;
#define PK4(P, B_, OUT) do { unsigned a0 = cvtpk(P[B_+0], P[B_+1]), a1 = cvtpk(P[B_+2], P[B_+3]);                          \
        unsigned b0 = cvtpk(P[B_+4], P[B_+5]), b1 = cvtpk(P[B_+6], P[B_+7]);                                             \
        auto r0 = __builtin_amdgcn_permlane32_swap(a0, b0, false, false); auto r1 = __builtin_amdgcn_permlane32_swap(a1, b1, false, false); \
        u32x4 w = {r0[0], r1[0], r0[1], r1[1]}; OUT = *reinterpret_cast<bf16x8*>(&w); } while (0)
    PK4(p0, 0, pa0); PK4(p0, 8, pa1); PK4(p1, 0, pa2); PK4(p1, 8, pa3);
#undef PK4
}
template <int KB>
__device__ __forceinline__ void qkt(f32x16& p0, f32x16& p1, const char* K_lds, const char* B_lds, int r32, int hi, const bf16x8* qr) {
    const char* bl = B_lds + KB * (KVBLK * 4) + hi * 16;
#pragma unroll
    for (int g = 0; g < 4; ++g) { const f32x4 b0 = *reinterpret_cast<const f32x4*>(bl + g * 32), b1 = *reinterpret_cast<const f32x4*>(bl + 128 + g * 32);
        p0[4 * g] = b0[0]; p0[4 * g + 1] = b0[1]; p0[4 * g + 2] = b0[2]; p0[4 * g + 3] = b0[3];
        p1[4 * g] = b1[0]; p1[4 * g + 1] = b1[1]; p1[4 * g + 2] = b1[2]; p1[4 * g + 3] = b1[3]; }
    const char* kb[4];
#pragma unroll
    for (int dd = 0; dd < 4; ++dd) kb[dd] = K_lds + KB * SHM_K + KSWZ(r32, (dd * 16 + hi * 8) * 2);
#pragma unroll
    for (int d0 = 0; d0 < 8; ++d0) { const char* a = kb[d0 & 3] + (d0 >> 2) * 128;
        bf16x8 b0 = *reinterpret_cast<const bf16x8*>(a);
        bf16x8 b1 = *reinterpret_cast<const bf16x8*>(a + 32 * 256);
        p0 = __builtin_amdgcn_mfma_f32_32x32x16_bf16(b0, qr[d0], p0, 0, 0, 0);
        p1 = __builtin_amdgcn_mfma_f32_32x32x16_bf16(b1, qr[d0], p1, 0, 0, 0); }
}
template <int VB>
__device__ __forceinline__ void pv_tile(f32x16* o, int vb0, bf16x8 pa0, bf16x8 pa1, bf16x8 pa2, bf16x8 pa3) {
#define TRRD(dst, off) asm volatile("ds_read_b64_tr_b16 %0, %1 offset:%2" : "=&v"(dst) : "v"(vb0), "i"(off) : "memory")
#define PV_D0(d0) do { s16x4 l0, l1, l2, l3, h0, h1, h2, h3; constexpr int b_ = VB * SHM_V + v_rd_off(d0, 0, 0);   \
        TRRD(l0, b_); TRRD(h0, b_ + 2048); TRRD(l1, b_ + 4096); TRRD(h1, b_ + 6144); TRRD(l2, b_ + 8192); TRRD(h2, b_ + 10240); TRRD(l3, b_ + 12288); TRRD(h3, b_ + 14336); \
        asm volatile("s_waitcnt lgkmcnt(0)" ::: "memory"); SBAR();   \
        o[d0] = __builtin_amdgcn_mfma_f32_32x32x16_bf16(pa0, (bf16x8){l0[0], l0[1], l0[2], l0[3], h0[0], h0[1], h0[2], h0[3]}, o[d0], 0, 0, 0);   \
        o[d0] = __builtin_amdgcn_mfma_f32_32x32x16_bf16(pa1, (bf16x8){l1[0], l1[1], l1[2], l1[3], h1[0], h1[1], h1[2], h1[3]}, o[d0], 0, 0, 0);   \
        o[d0] = __builtin_amdgcn_mfma_f32_32x32x16_bf16(pa2, (bf16x8){l2[0], l2[1], l2[2], l2[3], h2[0], h2[1], h2[2], h2[3]}, o[d0], 0, 0, 0);   \
        o[d0] = __builtin_amdgcn_mfma_f32_32x32x16_bf16(pa3, (bf16x8){l3[0], l3[1], l3[2], l3[3], h3[0], h3[1], h3[2], h3[3]}, o[d0], 0, 0, 0); } while (0)
    PV_D0(0); PV_D0(1); PV_D0(2); PV_D0(3);
#undef PV_D0
#undef TRRD
}
struct BlockRef { const bf16* Q; const bf16* K; const bf16* V; const float* bias; bf16* O; float* ML; int P0, W, dmask, ldo, flags; };
struct Seam { bf16x8 qr[8]; v2u st_v0, st_v1, st_k0, st_k1; float st_b; };
struct State { float m_reg, l_reg; f32x16 o[4]; };
__device__ __forceinline__ int swa_jlo(int P0, int W) { const int lowk = P0 - W + 1; return lowk > 0 ? lowk / KVBLK : 0; }
#define ROW(p, k0, rr) ((p) + (size_t)((k0) + (rr)) * D + sc)
#define VMW() asm volatile("s_waitcnt vmcnt(0)" ::: "memory")
#define VMWN(n) asm volatile("s_waitcnt vmcnt(%0)" :: "i"(n) : "memory")
#define ROW8(p, k0, rr) ((const unsigned char*)(p) + (size_t)(((k0) + (rr)) * D) + lo8)
#define WIDE8(w_) __builtin_bit_cast(bf16x8, (v4u){__builtin_bit_cast(unsigned, __builtin_amdgcn_cvt_scalef32_pk_bf16_fp8((w_).x, 1.0f, false)), __builtin_bit_cast(unsigned, __builtin_amdgcn_cvt_scalef32_pk_bf16_fp8((w_).x, 1.0f, true)), \
                                                    __builtin_bit_cast(unsigned, __builtin_amdgcn_cvt_scalef32_pk_bf16_fp8((w_).y, 1.0f, false)), __builtin_bit_cast(unsigned, __builtin_amdgcn_cvt_scalef32_pk_bf16_fp8((w_).y, 1.0f, true))})
#define SLOAD_H(Kp, Vp, Bp, k0) do { S.st_v0 = *(const v2u*)ROW8(Vp, k0, 0); S.st_v1 = *(const v2u*)ROW8(Vp, k0, 32);              \
                         S.st_k0 = *(const v2u*)ROW8(Kp, k0, 0); S.st_k1 = *(const v2u*)ROW8(Kp, k0, 32); S.st_b = *(const float*)((const char*)(Bp) + (size_t)((k0) * 4) + bo4); } while (0)
#define SWRITE_HK(bf) do { asm volatile("" : "+v"(S.st_k0), "+v"(S.st_k1)); *(bf16x8*)(K_lds + (bf) * SHM_K + kws) = WIDE8(S.st_k0); *(bf16x8*)(K_lds + (bf) * SHM_K + kws + 32 * 256) = WIDE8(S.st_k1); \
                           if (tid < 64) *(float*)(B_lds + (bf) * (KVBLK * 4) + tid * 4) = S.st_b; } while (0)
#define SWRITE_HV(bf) do { asm volatile("" : "+v"(S.st_v0), "+v"(S.st_v1)); *(bf16x8*)(V_lds + (bf) * SHM_V + vst0) = WIDE8(S.st_v0); *(bf16x8*)(V_lds + (bf) * SHM_V + vst1) = WIDE8(S.st_v1); } while (0)
#define SWRITE_H(bf) do { SWRITE_HV(bf); SWRITE_HK(bf); } while (0)
__device__ __forceinline__ float wave_max_valu(float v) {
    int x = __float_as_int(v); v = fmaxf(v, __int_as_float(__builtin_amdgcn_update_dpp(x, x, 0xB1, 0xf, 0xf, true)));
    x = __float_as_int(v); v = fmaxf(v, __int_as_float(__builtin_amdgcn_update_dpp(x, x, 0x4E, 0xf, 0xf, true)));
    x = __float_as_int(v); v = fmaxf(v, __int_as_float(__builtin_amdgcn_update_dpp(x, x, 0x141, 0xf, 0xf, true)));
    x = __float_as_int(v); v = fmaxf(v, __int_as_float(__builtin_amdgcn_update_dpp(x, x, 0x140, 0xf, 0xf, true)));
    auto a = __builtin_amdgcn_permlane16_swap(__float_as_uint(v), __float_as_uint(v), false, false); v = fmaxf(__uint_as_float(a[0]), __uint_as_float(a[1]));
    auto b = __builtin_amdgcn_permlane32_swap(__float_as_uint(v), __float_as_uint(v), false, false); return fmaxf(__uint_as_float(b[0]), __uint_as_float(b[1]));
}
struct Bg { const float* src; unsigned char* dst; float* scl; const float* srcU; unsigned char* dstU; int next, rstride, rowend, pend, first, gain; LAS unsigned char* slot; LAS unsigned char* gA; };
__device__ __forceinline__ void bg_consume(const Bg& bg, int lane) {
    float am = 0.f;
    const unsigned la = (unsigned)(uintptr_t)bg.slot + 16u * (unsigned)lane, lb = (unsigned)(uintptr_t)bg.slot + 64u * (unsigned)lane;
    const unsigned gd = (unsigned)(uintptr_t)bg.gA - (unsigned)(uintptr_t)bg.slot;
#define BG_RD1(x_, a_, o0_) asm volatile("ds_read_b128 %0, %1 offset:%2\n\ts_waitcnt lgkmcnt(0)" : "=&v"(x_) : "v"(a_), "i"(o0_) : "memory")
#define BG_RD2(x_, y_, a_, o0_, o1_) asm volatile("ds_read_b128 %0, %2 offset:%3\n\tds_read_b128 %1, %2 offset:%4\n\ts_waitcnt lgkmcnt(0)" : "=&v"(x_), "=&v"(y_) : "v"(a_), "i"(o0_), "i"(o1_) : "memory")
#pragma unroll
    for (int i = 0; i < 8; i += 2) { f32x4 x, y; BG_RD2(x, y, la, i * 1024, i * 1024 + 1024);
        if (bg.gain) { const unsigned ga = la + gd; f32x4 g; BG_RD1(g, ga, (i >> 2) * 13312 + (i & 3) * 1024); x *= g; asm volatile("" : "+v"(x)); BG_RD1(g, ga, (i >> 2) * 13312 + (i & 3) * 1024 + 1024); y *= g; }
        am = fmaxf(am, fmaxf(fmaxf(fabsf(x.x), fabsf(x.y)), fmaxf(fabsf(x.z), fabsf(x.w)))); am = fmaxf(am, fmaxf(fmaxf(fabsf(y.x), fabsf(y.y)), fmaxf(fabsf(y.z), fabsf(y.w)))); }
    am = wave_max_valu(am);
    const float inv = am > 0.f ? 7.5f / am : 0.f;
    v32h_t h;
#pragma unroll
    for (int j = 0; j < 8; j += 2) { f32x4 x, y; BG_RD2(x, y, lb, (j >> 2) * 4096 + 16 * (j & 3), (j >> 2) * 4096 + 16 * (j & 3) + 16);
        if (bg.gain) { const unsigned gb = lb + gd; f32x4 g; BG_RD1(g, gb, (j >> 2) * 13312 + 16 * (j & 3)); x *= g; asm volatile("" : "+v"(x)); BG_RD1(g, gb, (j >> 2) * 13312 + 16 * (j & 3) + 16); y *= g; }
        h[4 * j] = (_Float16)(x.x * inv); h[4 * j + 1] = (_Float16)(x.y * inv); h[4 * j + 2] = (_Float16)(x.z * inv); h[4 * j + 3] = (_Float16)(x.w * inv);
        h[4 * j + 4] = (_Float16)(y.x * inv); h[4 * j + 5] = (_Float16)(y.y * inv); h[4 * j + 6] = (_Float16)(y.z * inv); h[4 * j + 7] = (_Float16)(y.w * inv); }
#undef BG_RD2
#undef BG_RD1
    const v6u p = __builtin_amdgcn_cvt_scalef32_pk32_fp6_f16(h, 1.0f);
    unsigned char* rp = bg.dst + (size_t)bg.pend * F6_ROW;
    *(v4u*)(rp + 16 * lane) = (v4u){p[0], p[1], p[2], p[3]}; *(v2u*)(rp + 1024 + 8 * lane) = (v2u){p[4], p[5]};
    if (lane == 0) bg.scl[2 * (size_t)bg.pend] = am > 0.f ? am * (1.0f / 7.5f) : 1.0f;
}
__device__ __forceinline__ void bg_step(Bg& bg, int lane_in) {
    int lane = lane_in; asm volatile("s_waitcnt vmcnt(0)" : "+v"(lane) :: "memory");
    if (bg.pend >= 0) { bg_consume(bg, lane); asm volatile("s_waitcnt lgkmcnt(0)" ::: "memory"); }
    if (bg.next >= bg.rowend && !bg.gain) { bg.src = bg.srcU; bg.dst = bg.dstU; bg.scl -= 1; bg.next = bg.first; bg.gain = 1; }
    if (bg.next < bg.rowend) {
        const char* gp = (const char*)(bg.src + (size_t)bg.next * DM) + (unsigned)(lane * 16);
#pragma unroll
        for (int i = 0; i < 8; ++i) __builtin_amdgcn_global_load_lds((const unsigned*)(gp + i * 1024), (LAS unsigned*)(bg.slot + i * 1024), 16, 0, 0);
        bg.pend = bg.next; bg.next += bg.rstride;
    } else bg.pend = -1;
}
__device__ __forceinline__ void swa_prime(const BlockRef& cur, char* lds, Seam& S, const int tid) {
    const int wid = __builtin_amdgcn_readfirstlane(tid >> 6), lane = tid & 63, r32 = lane & 31, hi = lane >> 5;
    const int sr = tid >> 4, sc = (tid & 15) * 8, kws = KSWZ(sr, sc * 2); char* K_lds = lds + 2 * SHM_V; char* B_lds = lds + OFF_BIAS;
    const unsigned lo8 = (unsigned)(sr * D + sc), bo4 = (unsigned)((tid & 63) * 4);
    const int kb0 = swa_jlo(cur.P0, cur.W) * KVBLK;
    for (int d0 = 0; d0 < 8; ++d0) S.qr[d0] = *(const bf16x8*)((const char*)cur.Q + (size_t)(wid * QBLK * D * 2 + d0 * 32) + (unsigned)((r32 * D + hi * 8) * 2));
    SLOAD_H(cur.K, cur.V, cur.bias, kb0); VMW(); SWRITE_HK(0);
    __syncthreads();
}
__device__ __forceinline__ void swa_block(const BlockRef& cur, const BlockRef& nxt, char* lds, Seam& S, State& st, const int tid, Bg& bg) {
    const int wid = __builtin_amdgcn_readfirstlane(tid >> 6), lane = tid & 63, r32 = lane & 31, hi = lane >> 5;
    const int W = cur.W, dmask = cur.dmask;
    const int j_lo = swa_jlo(cur.P0, W);
    const int j_hi = (cur.P0 + QB - 1) / KVBLK + 1;
    const int NT = j_hi - j_lo;
    const int kbn = swa_jlo(nxt.P0, nxt.W) * KVBLK;
    const int qlo = cur.P0 + wid * QBLK, qm = qlo + r32 - 4 * hi;
    const bool cls = (cur.flags & 4) != 0; const unsigned Wl = (unsigned)((qlo + r32) & 127) + 1u;
    char* V_lds = lds; char* K_lds = lds + 2 * SHM_V; char* B_lds = lds + OFF_BIAS;
    float* ws = (float*)(lds + OFF_WS) + wid * 64; float* li_l = ws, * al_l = ws + 32;
    if (cur.flags & 1) { st.m_reg = -1e30f; st.l_reg = 0.f;
#pragma unroll
        for (int d_ = 0; d_ < 4; ++d_)
#pragma unroll
            for (int r = 0; r < 16; ++r) st.o[d_][r] = 0.f; }
    float& m_reg = st.m_reg; float& l_reg = st.l_reg; f32x16* o = st.o;
    const int sr = tid >> 4, sc = (tid & 15) * 8, vst0 = v_st(sr, sc), vst1 = v_st(32 + sr, sc), kws = KSWZ(sr, sc * 2);
    const unsigned lo8 = (unsigned)(sr * D + sc), bo4 = (unsigned)((tid & 63) * 4);
    const int vb0 = (int)(uintptr_t)V_lds + v_rd_base(lane);
    const bf16* Kh = cur.K; const bf16* Vh = cur.V; const float* Bh = cur.bias;
#define RESC(a) do { if (__any((a) < 1.f)) { if (hi == 0) al_l[r32] = (a); asm volatile("s_waitcnt lgkmcnt(0)" ::: "memory");              \
                     for (int d_ = 0; d_ < 4; ++d_) for (int r = 0; r < 16; ++r) o[d_][r] *= al_l[crow(r, hi)]; } } while (0)
#define KBASE(t) ((j_lo + (t)) * KVBLK)
#define MASKT(P0_, P1_, t) do { const int kb_ = KBASE(t); if (dmask) mask_tile<true>(P0_, P1_, qm - kb_, (unsigned)W, dmask); \
        else if (cls) mask_tile<false>(P0_, P1_, qm - kb_, Wl, 0); \
        else if (kb_ + KVBLK - 1 > qlo || kb_ <= qlo + QBLK - 1 - W) mask_tile<false>(P0_, P1_, qm - kb_, (unsigned)W, 0); } while (0)
    constexpr int NQL = 8;
#define SEAM_K0() do { VMWN(NQL); SWRITE_HK(0); SBAR(); } while (0)
    f32x16 pA0, pA1, pB0, pB1; float mnA, mnB, alA, alB; bf16x8 pa0, pa1, pa2, pa3;
    SWRITE_HV(0); SBAR();
    if (NT > 1) { SLOAD_H(Kh, Vh, Bh, KBASE(1)); }
    SBAR(); qkt<0>(pA0, pA1, K_lds, B_lds, r32, hi, S.qr);
    MASKT(pA0, pA1, 0); partialSM(pA0, pA1, m_reg, mnA, alA);
    if (NT > 1) { VMW(); SWRITE_H(1); }
    RESC(alA);
    __syncthreads();
#define LBAR() do { asm volatile("s_waitcnt lgkmcnt(0)" ::: "memory"); __builtin_amdgcn_s_barrier(); asm volatile("" ::: "memory"); } while (0)
#define HALF_STEP(PX0, PX1, mnX, alX, PY0, PY1, alY, t, KB, VB, SB) do {                                                      \
        SBAR(); qkt<KB>(PX0, PX1, K_lds, B_lds, r32, hi, S.qr);                                                  \
        finishSM(PY0, PY1, alY, l_reg, pa0, pa1, pa2, pa3); SBAR();                                                           \
        if ((t) + 1 < NT) { SLOAD_H(Kh, Vh, Bh, KBASE((t) + 1)); SBAR(); }                                                      \
        pv_tile<VB>(o, vb0, pa0, pa1, pa2, pa3); MASKT(PX0, PX1, (t)); partialSM(PX0, PX1, m_reg, mnX, alX);                   \
        LBAR();                                                                                                               \
        if ((t) + 1 < NT) { VMW(); SWRITE_H(SB); }                                                                            \
        RESC(alX); LBAR(); bg_step(bg, lane); } while (0)
    for (int t = 1; t + 1 < NT; t += 2) {
        HALF_STEP(pB0, pB1, mnB, alB, pA0, pA1, alA, t, 1, 0, 0);
        HALF_STEP(pA0, pA1, mnA, alA, pB0, pB1, alB, t + 1, 0, 1, 1);
    }
    const bool even = (NT & 1) == 0;
    if (even) { SBAR(); qkt<1>(pB0, pB1, K_lds, B_lds, r32, hi, S.qr); SBAR(); }
    SLOAD_H(nxt.K, nxt.V, nxt.bias, kbn); SBAR();
#pragma unroll
    for (int d0 = 0; d0 < 8; ++d0) S.qr[d0] = *(const bf16x8*)((const char*)nxt.Q + (size_t)(wid * QBLK * D * 2 + d0 * 32) + (unsigned)((r32 * D + hi * 8) * 2));
    SBAR();
    finishSM(pA0, pA1, alA, l_reg, pa0, pa1, pa2, pa3); SBAR();
    pv_tile<0>(o, vb0, pa0, pa1, pa2, pa3);
    if (even) { MASKT(pB0, pB1, NT - 1); partialSM(pB0, pB1, m_reg, mnB, alB); __syncthreads(); RESC(alB);
        finishSM(pB0, pB1, alB, l_reg, pa0, pa1, pa2, pa3); SBAR(); pv_tile<1>(o, vb0, pa0, pa1, pa2, pa3); }
    SBAR(); SEAM_K0();
    if (cur.flags & 2) {
        if (cur.ML != nullptr && hi == 0) { v2u ml_; ml_.x = __float_as_uint(m_reg); ml_.y = __float_as_uint(l_reg); *(v2u*)(cur.ML + (size_t)(cls ? cls_pos(qlo + r32) : wid * QBLK + r32) * 8) = ml_; }
        if (hi == 0) li_l[r32] = l_reg; asm volatile("s_waitcnt lgkmcnt(0)" ::: "memory");
        const bool f8 = (cur.flags & 8) != 0; const int es = f8 ? 0 : 1; const float osc = f8 ? (float)(1 << O_SHIFT) : 1.0f;
        unsigned char* Ow = (unsigned char*)cur.O + ((cls ? (size_t)0 : (size_t)(wid * QBLK) * cur.ldo) << es);
#define DPPX(v_, ctl_) __int_as_float(__builtin_amdgcn_update_dpp(0, __float_as_int(v_), ctl_, 0xf, 0xf, true))
        int r32e = r32; asm volatile("" : "+v"(r32e));
        const bool q0 = (r32e & 1) != 0, q1 = (r32e & 2) != 0;
#pragma unroll
        for (int g = 0; g < 4; ++g) { const int rloc = 8 * g + 4 * hi + (r32e & 3); const int orow = cls ? cls_pos(qlo + rloc) : rloc;
            float rli[4];
#pragma unroll
            for (int j = 0; j < 4; ++j) rli[j] = __builtin_amdgcn_rcpf(li_l[crow(4 * g + j, hi)]) * osc;
#pragma unroll
            for (int d0 = 0; d0 < 4; ++d0) {
                const float a0 = o[d0][4 * g] * rli[0], a1 = o[d0][4 * g + 1] * rli[1], a2 = o[d0][4 * g + 2] * rli[2], a3 = o[d0][4 * g + 3] * rli[3];
                const float x0 = DPPX(a0, 0xB1), x1 = DPPX(a1, 0xB1), x2 = DPPX(a2, 0xB1), x3 = DPPX(a3, 0xB1);
                const float s0 = q0 ? x1 : a0, s1 = q0 ? a1 : x0, s2 = q0 ? x3 : a2, s3 = q0 ? a3 : x2;
                const float y0 = DPPX(s0, 0x4E), y1 = DPPX(s1, 0x4E), y2 = DPPX(s2, 0x4E), y3 = DPPX(s3, 0x4E);
                const float t0 = q1 ? y2 : s0, t1 = q1 ? y3 : s1, t2 = q1 ? s2 : y0, t3 = q1 ? s3 : y1;
                unsigned char* p_ = Ow + (((size_t)orow * cur.ldo + d0 * 32 + (r32e & ~3)) << es);
                if (f8) { int w_ = __builtin_amdgcn_cvt_pk_fp8_f32(t0, t1, 0, false); w_ = __builtin_amdgcn_cvt_pk_fp8_f32(t2, t3, w_, true); *(unsigned*)p_ = (unsigned)w_; }
                else *(v2u*)p_ = (v2u){cvtpk(t0, t1), cvtpk(t2, t3)};
                __builtin_amdgcn_sched_barrier(0); } }
#undef DPPX
    }
    __syncthreads();
#undef RESC
#undef KBASE
#undef MASKT
#undef SEAM_K0
#undef HALF_STEP
}
#undef ROW
#undef VMW
#undef VMWN
#undef SLOAD_H
#undef SWRITE_HK
#undef SWRITE_HV
#undef SWRITE_H
#undef KSWZ
#undef SBAR
}

constexpr int SCHED_MAX = 3;
__device__ const unsigned short ATT_SCHED[256][SCHED_MAX] = {
{511,65535,65535},
{503,65535,65535},
{495,65535,65535},
{487,65535,65535},
{479,65535,65535},
{471,65535,65535},
{463,65535,65535},
{455,65535,65535},
{447,65535,65535},
{439,65535,65535},
{431,65535,65535},
{423,65535,65535},
{415,65535,65535},
{407,65535,65535},
{399,65535,65535},
{391,65535,65535},
{383,65535,65535},
{375,65535,65535},
{367,65535,65535},
{359,65535,65535},
{351,65535,65535},
{343,65535,65535},
{335,65535,65535},
{327,65535,65535},
{319,65535,65535},
{311,65535,65535},
{303,65535,65535},
{295,65535,65535},
{287,65535,65535},
{279,65535,65535},
{271,65535,65535},
{263,65535,65535},
{510,65535,65535},
{502,65535,65535},
{494,65535,65535},
{486,65535,65535},
{478,65535,65535},
{470,65535,65535},
{462,65535,65535},
{454,65535,65535},
{446,65535,65535},
{438,65535,65535},
{430,65535,65535},
{422,65535,65535},
{414,65535,65535},
{406,65535,65535},
{398,65535,65535},
{390,65535,65535},
{382,65535,65535},
{374,65535,65535},
{366,65535,65535},
{358,65535,65535},
{350,65535,65535},
{342,65535,65535},
{334,65535,65535},
{326,65535,65535},
{318,65535,65535},
{310,65535,65535},
{302,65535,65535},
{294,65535,65535},
{286,65535,65535},
{278,65535,65535},
{270,65535,65535},
{262,65535,65535},
{509,223,65535},
{501,222,65535},
{493,221,65535},
{485,220,65535},
{477,219,65535},
{469,218,65535},
{461,217,65535},
{453,216,65535},
{445,215,65535},
{437,214,65535},
{429,213,65535},
{421,212,65535},
{413,211,65535},
{405,210,65535},
{397,209,65535},
{389,208,65535},
{381,207,65535},
{373,206,65535},
{365,205,65535},
{357,204,65535},
{349,203,65535},
{341,202,65535},
{333,201,65535},
{325,200,65535},
{317,199,65535},
{309,198,65535},
{301,197,65535},
{293,196,65535},
{285,195,65535},
{277,194,65535},
{269,193,65535},
{261,192,65535},
{508,255,159},
{500,254,158},
{492,253,157},
{484,252,156},
{476,251,155},
{468,250,154},
{460,249,153},
{452,248,152},
{444,247,151},
{436,246,150},
{428,245,149},
{420,244,148},
{412,243,147},
{404,242,146},
{396,241,145},
{388,240,144},
{380,239,143},
{372,238,142},
{364,237,141},
{356,236,140},
{348,235,139},
{340,234,138},
{332,233,137},
{324,232,136},
{316,231,135},
{308,230,134},
{300,229,133},
{292,228,132},
{284,227,131},
{276,226,130},
{268,225,129},
{260,224,128},
{127,378,65535},
{126,370,65535},
{125,362,65535},
{124,354,65535},
{123,346,65535},
{122,338,65535},
{119,330,65535},
{118,322,65535},
{117,314,65535},
{116,306,65535},
{115,298,65535},
{114,290,65535},
{111,282,65535},
{110,274,65535},
{109,266,65535},
{108,258,65535},
{107,120,65535},
{106,112,65535},
{103,104,65535},
{102,96,65535},
{101,88,65535},
{100,80,65535},
{99,72,65535},
{98,64,65535},
{95,56,65535},
{94,48,65535},
{93,40,65535},
{92,32,65535},
{91,24,65535},
{90,16,65535},
{87,8,65535},
{86,0,65535},
{85,505,65535},
{84,497,65535},
{83,489,65535},
{82,481,65535},
{79,473,65535},
{78,465,65535},
{77,457,65535},
{76,449,65535},
{75,441,65535},
{74,433,65535},
{71,425,65535},
{70,417,65535},
{69,409,65535},
{68,401,65535},
{67,393,65535},
{66,385,65535},
{63,377,65535},
{62,369,65535},
{61,361,65535},
{60,353,65535},
{59,345,65535},
{58,337,65535},
{55,329,65535},
{54,321,65535},
{53,313,65535},
{52,305,65535},
{51,297,65535},
{50,289,65535},
{47,281,65535},
{46,273,65535},
{45,265,65535},
{44,257,65535},
{43,504,191},
{42,496,190},
{39,488,189},
{38,480,188},
{37,472,187},
{36,464,186},
{35,456,185},
{34,448,184},
{31,440,183},
{30,432,182},
{29,424,181},
{28,416,180},
{27,408,179},
{26,400,178},
{23,392,177},
{22,384,176},
{21,376,175},
{20,368,174},
{19,360,173},
{18,352,172},
{15,344,171},
{14,336,170},
{13,328,169},
{12,320,168},
{11,312,167},
{10,304,166},
{7,296,165},
{6,288,164},
{5,280,163},
{4,272,162},
{3,264,161},
{2,256,160},
{507,121,65535},
{499,113,65535},
{491,105,65535},
{483,97,65535},
{475,89,65535},
{467,81,65535},
{459,73,65535},
{451,65,65535},
{443,57,65535},
{435,49,65535},
{427,41,65535},
{419,33,65535},
{411,25,65535},
{403,17,65535},
{395,9,65535},
{387,1,65535},
{379,506,65535},
{371,498,65535},
{363,490,65535},
{355,482,65535},
{347,474,65535},
{339,466,65535},
{331,458,65535},
{323,450,65535},
{315,442,65535},
{307,434,65535},
{299,426,65535},
{291,418,65535},
{283,410,65535},
{275,402,65535},
{267,394,65535},
{259,386,65535}
};
struct AttPtrs { const bf16_t* Q; const bf16_t* K; const bf16_t* V; const float* kbias; const float* zbias; bf16_t* O01; bf16_t* O2; float* ML01; float* ML2; bf16_t* OB; };
constexpr int ATT_NITEMS = 128 + 128 + 256;
__device__ __forceinline__ att::BlockRef att_ref(const AttPtrs& P, int code, int sub) {
    att::BlockRef r;
    if (code < 256) {
        const int c2 = code & 127, b = c2 >> 5, slot = (c2 >> 3) & 3, qb = c2 & 7, g = code < 128 ? 1 - sub : 2, dil = g == 0 ? 1 : (g == 1 ? 4 : 16), head = g * 4 + slot;
        const size_t hb = ((size_t)b * NHEADS + head) * SEQ * HD;
        r.Q = P.Q + hb + (size_t)qb * 256 * HD; r.K = (const bf16_t*)((const unsigned char*)P.K + hb); r.V = (const bf16_t*)((const unsigned char*)P.V + hb); r.bias = P.zbias;
        r.ldo = A_OUT; r.P0 = qb * 256;
        if (code < 128) { r.O = P.O01 + ((size_t)b * SEQ + qb * 256) * A_OUT + slot * HD; r.ML = P.ML01 + (((size_t)b * SEQ + qb * 256) * 4 + slot) * 2;
            r.W = 128 * dil + 1; r.dmask = dil - 1; r.flags = (sub == 0 ? 1 : 0) | (sub == 1 ? 2 : 0); }
        else {
            r.O = P.O2 + ((size_t)b * SEQ) * A_OUT + slot * HD; r.ML = P.ML2 + (((size_t)b * SEQ) * 4 + slot) * 2; r.W = 1; r.dmask = 0; r.flags = 3 | 4; }
    } else {
        const int c2 = code - 256, bh = c2 >> 3, qb = c2 & 7, b = bh >> 3, h = bh & 7;
        const size_t hb = ((size_t)b * NHEADS + DIL_HEADS + h) * SEQ * HD;
        r.Q = P.Q + hb + (size_t)qb * 256 * HD; r.K = (const bf16_t*)((const unsigned char*)P.K + hb); r.V = (const bf16_t*)((const unsigned char*)P.V + hb); r.bias = P.kbias + (size_t)bh * SEQ;
        r.O = (bf16_t*)((unsigned char*)P.OB + ((size_t)b * SEQ + qb * 256) * B_OUT + h * HD); r.ldo = B_OUT; r.ML = nullptr;
        r.P0 = qb * 256; r.W = 1 << 20; r.dmask = 0; r.flags = 3 | 8;
    }
    return r;
}
__device__ __forceinline__ bool att_nth(const AttPtrs& P, int w, int G, int n, att::BlockRef& r) {
    for (int k = 0;; ++k) {
        int code;
        if (G == 256) { if (k >= SCHED_MAX) return false; code = ATT_SCHED[w][k]; if (code == 0xFFFF) return false; }
        else { code = w + k * G; if (code >= ATT_NITEMS) return false; }
        const int ns = code < 128 ? 2 : 1;
        if (n < ns) { r = att_ref(P, code, n); return true; }
        n -= ns;
    }
}
__device__ __forceinline__ void phase_attn(const AttPtrs& P, char* lds, const int tid, att::Bg& bg) {
    const int w = blockIdx.x, G = gridDim.x;
    att::BlockRef cur, nxt;
    if (!att_nth(P, w, G, 0, cur)) return;
    att::Seam S; att::State st;
    att::swa_prime(cur, lds, S, tid);
    for (int n = 0;; ++n) {
        const bool more = att_nth(P, w, G, n + 1, nxt);
        if (!more) nxt = cur;
        att::swa_block(cur, nxt, lds, S, st, tid, bg);
        if (!more) break;
        cur = nxt;
    }
}

__device__ __forceinline__ void phase_attn_combine(const bf16_t* O01, const bf16_t* O2, const float* ML01, const float* ML2, unsigned char* OA8, const bf16_t* OB, unsigned char* OB8, const Ctx& c) {
    constexpr float OS = (float)(1 << O_SHIFT);
    for (int i = blockIdx.x * NTHREADS + c.tid; i < T * 4 * 16; i += gridDim.x * NTHREADS) {
        const int rs = i >> 4, ch = i & 15;
        const v2u a = *(const v2u*)(ML01 + (size_t)rs * 2), b = *(const v2u*)(ML2 + (size_t)rs * 2);
        const float m1 = __uint_as_float(a.x), l1 = __uint_as_float(a.y), m2 = __uint_as_float(b.x), l2 = __uint_as_float(b.y), M = fmaxf(m1, m2);
        float w1 = l1 * exp2f(m1 - M), w2 = l2 * exp2f(m2 - M); const float inv = 1.0f / (w1 + w2); w1 *= inv; w2 *= inv;
        const size_t o = (size_t)rs * HD + ch * 8;
        const v4u x = *(const v4u*)(O01 + o), y = *(const v4u*)(O2 + o);
        w1 *= OS; w2 *= OS;
        int p0 = __builtin_amdgcn_cvt_pk_fp8_f32(w1 * bflo(x.x) + w2 * bflo(y.x), w1 * bfhi(x.x) + w2 * bfhi(y.x), 0, false); p0 = __builtin_amdgcn_cvt_pk_fp8_f32(w1 * bflo(x.y) + w2 * bflo(y.y), w1 * bfhi(x.y) + w2 * bfhi(y.y), p0, true);
        int p1 = __builtin_amdgcn_cvt_pk_fp8_f32(w1 * bflo(x.z) + w2 * bflo(y.z), w1 * bfhi(x.z) + w2 * bfhi(y.z), 0, false); p1 = __builtin_amdgcn_cvt_pk_fp8_f32(w1 * bflo(x.w) + w2 * bflo(y.w), w1 * bfhi(x.w) + w2 * bfhi(y.w), p1, true);
        *(v2u*)(OA8 + o) = (v2u){(unsigned)p0, (unsigned)p1};
    }
}
__device__ __forceinline__ float gelu_exact(float x) { return 0.5f * x * (1.0f + erff(x * 0.70710678118654752f)); }
__device__ __forceinline__ void phase_peer_naive(const bf16_t* xn, const bf16_t* query, const bf16_t* sk_l, const bf16_t* eu_l, const bf16_t* ev_l, const float* x1, float* xout, const Ctx& c) {
    for (int t = c.gw; t < T; t += c.ngw) {
        v4u xr[4];
#pragma unroll
        for (int j = 0; j < 4; ++j) xr[j] = ((const v4u*)(xn + (size_t)t * DM))[c.lane + 64 * j];
        float acc[32];
#pragma unroll
        for (int i = 0; i < 32; ++i) acc[i] = 0.f;
#pragma unroll 1
        for (int h = 0; h < PEER_HEADS; ++h) {
            unsigned top[2];
#pragma unroll
            for (int hc = 0; hc < 2; ++hc) {
                const v4u* qp = (const v4u*)(query + (size_t)t * DM + h * 256 + hc * 128);
                const v4u* k0p = (const v4u*)(sk_l + (((size_t)h * 2 + hc) * NKEYS + c.lane) * HD);
                const v4u* k1p = (const v4u*)(sk_l + (((size_t)h * 2 + hc) * NKEYS + c.lane + 64) * HD);
                float s0 = 0.f, s1 = 0.f;
#pragma unroll 4
                for (int k = 0; k < 16; ++k) { const v4u q = qp[k], a = k0p[k], b = k1p[k];
                    s0 = dot2(q.x, a.x, s0); s0 = dot2(q.y, a.y, s0); s0 = dot2(q.z, a.z, s0); s0 = dot2(q.w, a.w, s0);
                    s1 = dot2(q.x, b.x, s1); s1 = dot2(q.y, b.y, s1); s1 = dot2(q.z, b.z, s1); s1 = dot2(q.w, b.w, s1); }
                unsigned p0 = (ord_f(s0) & ~127u) | (unsigned)c.lane, p1 = (ord_f(s1) & ~127u) | (unsigned)(c.lane + 64);
                unsigned mine = 0u;
#pragma unroll 1
                for (int i = 0; i < TOPK; ++i) {
                    const unsigned mx = wave_max_u(p0 > p1 ? p0 : p1);
                    if (p0 == mx) p0 = 0u; if (p1 == mx) p1 = 0u;
                    if (c.lane == i) mine = mx;
                }
                top[hc] = mine;
            }
            const float v0 = unord_f((unsigned)__shfl((int)top[0], c.lane & 15) & ~127u);
            unsigned cand[4];
#pragma unroll
            for (int r = 0; r < 4; ++r) { const int j = (c.lane >> 4) + 4 * r; const float v1 = unord_f((unsigned)__shfl((int)top[1], j) & ~127u);
                cand[r] = (ord_f(v0 + v1) & ~255u) | (unsigned)((c.lane & 15) * 16 + j); }
            unsigned best = 0u;
#pragma unroll 1
            for (int i = 0; i < TOPK; ++i) {
                unsigned mloc = cand[0] > cand[1] ? cand[0] : cand[1]; const unsigned m2 = cand[2] > cand[3] ? cand[2] : cand[3]; mloc = mloc > m2 ? mloc : m2;
                const unsigned mx = wave_max_u(mloc);
#pragma unroll
                for (int r = 0; r < 4; ++r) if (cand[r] == mx) cand[r] = 0u;
                if (c.lane == i) best = mx;
            }
            const int bi = (int)((best >> 4) & 15u), bj = (int)(best & 15u);
            const unsigned i0 = (unsigned)__shfl((int)top[0], bi) & 127u, i1 = (unsigned)__shfl((int)top[1], bj) & 127u;
            const int expert = (int)(i0 * NKEYS + i1);
            const float bs = unord_f(best & ~255u);
            const float bmax = __shfl(bs, 0);
            const float e = c.lane < TOPK ? expf(bs - bmax) : 0.f;
            const float gate = e / wave_sum(e);
#pragma unroll 1
            for (int r = 0; r < TOPK; ++r) {
                const int ex = __shfl(expert, r); const float g = __shfl(gate, r);
                const v4u* up = (const v4u*)(eu_l + (size_t)ex * DM); const v4u* vp = (const v4u*)(ev_l + (size_t)ex * DM);
                float d = 0.f;
#pragma unroll
                for (int j = 0; j < 4; ++j) { const v4u u = up[c.lane + 64 * j]; d = dot2(u.x, xr[j].x, d); d = dot2(u.y, xr[j].y, d); d = dot2(u.z, xr[j].z, d); d = dot2(u.w, xr[j].w, d); }
                d = wave_sum(d);
                const float w = g * gelu_exact(d);
#pragma unroll
                for (int j = 0; j < 4; ++j) { const v4u vv = vp[c.lane + 64 * j];
                    acc[8 * j + 0] += w * bflo(vv.x); acc[8 * j + 1] += w * bfhi(vv.x); acc[8 * j + 2] += w * bflo(vv.y); acc[8 * j + 3] += w * bfhi(vv.y);
                    acc[8 * j + 4] += w * bflo(vv.z); acc[8 * j + 5] += w * bfhi(vv.z); acc[8 * j + 6] += w * bflo(vv.w); acc[8 * j + 7] += w * bfhi(vv.w); }
            }
        }
#pragma unroll
        for (int j = 0; j < 4; ++j) {
            const size_t o = (size_t)t * DM + 8 * (c.lane + 64 * j);
            const f32x4 a = *(const f32x4*)(x1 + o), b = *(const f32x4*)(x1 + o + 4);
            f32x4 ra, rb; ra.x = a.x + acc[8 * j + 0]; ra.y = a.y + acc[8 * j + 1]; ra.z = a.z + acc[8 * j + 2]; ra.w = a.w + acc[8 * j + 3];
            rb.x = b.x + acc[8 * j + 4]; rb.y = b.y + acc[8 * j + 5]; rb.z = b.z + acc[8 * j + 6]; rb.w = b.w + acc[8 * j + 7];
            *(f32x4*)(xout + o) = ra; *(f32x4*)(xout + o + 4) = rb;
        }
    }
}

namespace peer {
constexpr int CH = 32, L_LIST = 0, L_TAB = 32768, L_STAB = 65536, L_ML2 = 98304, LDS_BYTES_PEER = 131072;
typedef short bf16x8 __attribute__((ext_vector_type(8)));
typedef float f32x16 __attribute__((ext_vector_type(16)));
__device__ __forceinline__ unsigned umax(unsigned a, unsigned b) { return a > b ? a : b; }
__device__ __forceinline__ unsigned umin(unsigned a, unsigned b) { return a < b ? a : b; }
__device__ __forceinline__ unsigned pair_max(unsigned m) { auto rr = __builtin_amdgcn_permlane32_swap(m, m, false, false); return umax(rr[0], rr[1]); }
struct Stair { int i[50], j[50]; };
constexpr Stair make_stair() { Stair s{}; int n = 0; for (int i = 0; i < 16; ++i) for (int j = 0; j < 16; ++j) if ((i + 1) * (j + 1) <= 16) { s.i[n] = i; s.j[n] = j; ++n; } return s; }
constexpr Stair STAIR = make_stair();
constexpr int lane_of(int e) { return (((e >> 3) & 1) << 5) | (((e >> 2) & 1) << 4) | (((e >> 1) & 1) << 3) | ((e & 1) << 2); }
__device__ __forceinline__ int slot_of(int lane) { return (((lane >> 5) & 1) << 3) | (((lane >> 4) & 1) << 2) | (((lane >> 3) & 1) << 1) | ((lane >> 2) & 1); }

#define PEER_CE(a_, b_) do { const unsigned t_ = umax(v[a_], v[b_]); v[b_] = umin(v[a_], v[b_]); v[a_] = t_; } while (0)
__device__ __forceinline__ void top16_pair(unsigned (&v)[64], int hi) {
    PEER_CE(0, 1); PEER_CE(2, 3); PEER_CE(0, 2); PEER_CE(1, 3); PEER_CE(1, 2); PEER_CE(4, 5); PEER_CE(6, 7); PEER_CE(4, 6); PEER_CE(5, 7); PEER_CE(5, 6); PEER_CE(0, 4); PEER_CE(2, 6); PEER_CE(2, 4); PEER_CE(1, 5); PEER_CE(3, 7); PEER_CE(3, 5); PEER_CE(1, 2); PEER_CE(3, 4); PEER_CE(5, 6); PEER_CE(8, 9); PEER_CE(10, 11); PEER_CE(8, 10); PEER_CE(9, 11); PEER_CE(9, 10); PEER_CE(12, 13); PEER_CE(14, 15); PEER_CE(12, 14); PEER_CE(13, 15); PEER_CE(13, 14); PEER_CE(8, 12); PEER_CE(10, 14); PEER_CE(10, 12); PEER_CE(9, 13); PEER_CE(11, 15); PEER_CE(11, 13); PEER_CE(9, 10); PEER_CE(11, 12); PEER_CE(13, 14); PEER_CE(0, 8); PEER_CE(4, 12); PEER_CE(4, 8); PEER_CE(2, 10); PEER_CE(6, 14); PEER_CE(6, 10); PEER_CE(2, 4); PEER_CE(6, 8); PEER_CE(10, 12); PEER_CE(1, 9); PEER_CE(5, 13); PEER_CE(5, 9); PEER_CE(3, 11); PEER_CE(7, 15); PEER_CE(7, 11); PEER_CE(3, 5); PEER_CE(7, 9); PEER_CE(11, 13); PEER_CE(1, 2); PEER_CE(3, 4); PEER_CE(5, 6); PEER_CE(7, 8); PEER_CE(9, 10); PEER_CE(11, 12); PEER_CE(13, 14);
    PEER_CE(16, 17); PEER_CE(18, 19); PEER_CE(16, 18); PEER_CE(17, 19); PEER_CE(17, 18); PEER_CE(20, 21); PEER_CE(22, 23); PEER_CE(20, 22); PEER_CE(21, 23); PEER_CE(21, 22); PEER_CE(16, 20); PEER_CE(18, 22); PEER_CE(18, 20); PEER_CE(17, 21); PEER_CE(19, 23); PEER_CE(19, 21); PEER_CE(17, 18); PEER_CE(19, 20); PEER_CE(21, 22); PEER_CE(24, 25); PEER_CE(26, 27); PEER_CE(24, 26); PEER_CE(25, 27); PEER_CE(25, 26); PEER_CE(28, 29); PEER_CE(30, 31); PEER_CE(28, 30); PEER_CE(29, 31); PEER_CE(29, 30); PEER_CE(24, 28); PEER_CE(26, 30); PEER_CE(26, 28); PEER_CE(25, 29); PEER_CE(27, 31); PEER_CE(27, 29); PEER_CE(25, 26); PEER_CE(27, 28); PEER_CE(29, 30); PEER_CE(16, 24); PEER_CE(20, 28); PEER_CE(20, 24); PEER_CE(18, 26); PEER_CE(22, 30); PEER_CE(22, 26); PEER_CE(18, 20); PEER_CE(22, 24); PEER_CE(26, 28); PEER_CE(17, 25); PEER_CE(21, 29); PEER_CE(21, 25); PEER_CE(19, 27); PEER_CE(23, 31); PEER_CE(23, 27); PEER_CE(19, 21); PEER_CE(23, 25); PEER_CE(27, 29); PEER_CE(17, 18); PEER_CE(19, 20); PEER_CE(21, 22); PEER_CE(23, 24); PEER_CE(25, 26); PEER_CE(27, 28); PEER_CE(29, 30);
    PEER_CE(32, 33); PEER_CE(34, 35); PEER_CE(32, 34); PEER_CE(33, 35); PEER_CE(33, 34); PEER_CE(36, 37); PEER_CE(38, 39); PEER_CE(36, 38); PEER_CE(37, 39); PEER_CE(37, 38); PEER_CE(32, 36); PEER_CE(34, 38); PEER_CE(34, 36); PEER_CE(33, 37); PEER_CE(35, 39); PEER_CE(35, 37); PEER_CE(33, 34); PEER_CE(35, 36); PEER_CE(37, 38); PEER_CE(40, 41); PEER_CE(42, 43); PEER_CE(40, 42); PEER_CE(41, 43); PEER_CE(41, 42); PEER_CE(44, 45); PEER_CE(46, 47); PEER_CE(44, 46); PEER_CE(45, 47); PEER_CE(45, 46); PEER_CE(40, 44); PEER_CE(42, 46); PEER_CE(42, 44); PEER_CE(41, 45); PEER_CE(43, 47); PEER_CE(43, 45); PEER_CE(41, 42); PEER_CE(43, 44); PEER_CE(45, 46); PEER_CE(32, 40); PEER_CE(36, 44); PEER_CE(36, 40); PEER_CE(34, 42); PEER_CE(38, 46); PEER_CE(38, 42); PEER_CE(34, 36); PEER_CE(38, 40); PEER_CE(42, 44); PEER_CE(33, 41); PEER_CE(37, 45); PEER_CE(37, 41); PEER_CE(35, 43); PEER_CE(39, 47); PEER_CE(39, 43); PEER_CE(35, 37); PEER_CE(39, 41); PEER_CE(43, 45); PEER_CE(33, 34); PEER_CE(35, 36); PEER_CE(37, 38); PEER_CE(39, 40); PEER_CE(41, 42); PEER_CE(43, 44); PEER_CE(45, 46);
    PEER_CE(48, 49); PEER_CE(50, 51); PEER_CE(48, 50); PEER_CE(49, 51); PEER_CE(49, 50); PEER_CE(52, 53); PEER_CE(54, 55); PEER_CE(52, 54); PEER_CE(53, 55); PEER_CE(53, 54); PEER_CE(48, 52); PEER_CE(50, 54); PEER_CE(50, 52); PEER_CE(49, 53); PEER_CE(51, 55); PEER_CE(51, 53); PEER_CE(49, 50); PEER_CE(51, 52); PEER_CE(53, 54); PEER_CE(56, 57); PEER_CE(58, 59); PEER_CE(56, 58); PEER_CE(57, 59); PEER_CE(57, 58); PEER_CE(60, 61); PEER_CE(62, 63); PEER_CE(60, 62); PEER_CE(61, 63); PEER_CE(61, 62); PEER_CE(56, 60); PEER_CE(58, 62); PEER_CE(58, 60); PEER_CE(57, 61); PEER_CE(59, 63); PEER_CE(59, 61); PEER_CE(57, 58); PEER_CE(59, 60); PEER_CE(61, 62); PEER_CE(48, 56); PEER_CE(52, 60); PEER_CE(52, 56); PEER_CE(50, 58); PEER_CE(54, 62); PEER_CE(54, 58); PEER_CE(50, 52); PEER_CE(54, 56); PEER_CE(58, 60); PEER_CE(49, 57); PEER_CE(53, 61); PEER_CE(53, 57); PEER_CE(51, 59); PEER_CE(55, 63); PEER_CE(55, 59); PEER_CE(51, 53); PEER_CE(55, 57); PEER_CE(59, 61); PEER_CE(49, 50); PEER_CE(51, 52); PEER_CE(53, 54); PEER_CE(55, 56); PEER_CE(57, 58); PEER_CE(59, 60); PEER_CE(61, 62);
    v[0] = umax(v[0], v[31]); v[1] = umax(v[1], v[30]); v[2] = umax(v[2], v[29]); v[3] = umax(v[3], v[28]); v[4] = umax(v[4], v[27]); v[5] = umax(v[5], v[26]); v[6] = umax(v[6], v[25]); v[7] = umax(v[7], v[24]); v[8] = umax(v[8], v[23]); v[9] = umax(v[9], v[22]); v[10] = umax(v[10], v[21]); v[11] = umax(v[11], v[20]); v[12] = umax(v[12], v[19]); v[13] = umax(v[13], v[18]); v[14] = umax(v[14], v[17]); v[15] = umax(v[15], v[16]);
    PEER_CE(0, 8); PEER_CE(1, 9); PEER_CE(2, 10); PEER_CE(3, 11); PEER_CE(4, 12); PEER_CE(5, 13); PEER_CE(6, 14); PEER_CE(7, 15); PEER_CE(0, 4); PEER_CE(1, 5); PEER_CE(2, 6); PEER_CE(3, 7); PEER_CE(0, 2); PEER_CE(1, 3); PEER_CE(0, 1); PEER_CE(2, 3); PEER_CE(4, 6); PEER_CE(5, 7); PEER_CE(4, 5); PEER_CE(6, 7); PEER_CE(8, 12); PEER_CE(9, 13); PEER_CE(10, 14); PEER_CE(11, 15); PEER_CE(8, 10); PEER_CE(9, 11); PEER_CE(8, 9); PEER_CE(10, 11); PEER_CE(12, 14); PEER_CE(13, 15); PEER_CE(12, 13); PEER_CE(14, 15);
    v[32] = umax(v[32], v[63]); v[33] = umax(v[33], v[62]); v[34] = umax(v[34], v[61]); v[35] = umax(v[35], v[60]); v[36] = umax(v[36], v[59]); v[37] = umax(v[37], v[58]); v[38] = umax(v[38], v[57]); v[39] = umax(v[39], v[56]); v[40] = umax(v[40], v[55]); v[41] = umax(v[41], v[54]); v[42] = umax(v[42], v[53]); v[43] = umax(v[43], v[52]); v[44] = umax(v[44], v[51]); v[45] = umax(v[45], v[50]); v[46] = umax(v[46], v[49]); v[47] = umax(v[47], v[48]);
    PEER_CE(32, 40); PEER_CE(33, 41); PEER_CE(34, 42); PEER_CE(35, 43); PEER_CE(36, 44); PEER_CE(37, 45); PEER_CE(38, 46); PEER_CE(39, 47); PEER_CE(32, 36); PEER_CE(33, 37); PEER_CE(34, 38); PEER_CE(35, 39); PEER_CE(32, 34); PEER_CE(33, 35); PEER_CE(32, 33); PEER_CE(34, 35); PEER_CE(36, 38); PEER_CE(37, 39); PEER_CE(36, 37); PEER_CE(38, 39); PEER_CE(40, 44); PEER_CE(41, 45); PEER_CE(42, 46); PEER_CE(43, 47); PEER_CE(40, 42); PEER_CE(41, 43); PEER_CE(40, 41); PEER_CE(42, 43); PEER_CE(44, 46); PEER_CE(45, 47); PEER_CE(44, 45); PEER_CE(46, 47);
    v[0] = umax(v[0], v[47]); v[1] = umax(v[1], v[46]); v[2] = umax(v[2], v[45]); v[3] = umax(v[3], v[44]); v[4] = umax(v[4], v[43]); v[5] = umax(v[5], v[42]); v[6] = umax(v[6], v[41]); v[7] = umax(v[7], v[40]); v[8] = umax(v[8], v[39]); v[9] = umax(v[9], v[38]); v[10] = umax(v[10], v[37]); v[11] = umax(v[11], v[36]); v[12] = umax(v[12], v[35]); v[13] = umax(v[13], v[34]); v[14] = umax(v[14], v[33]); v[15] = umax(v[15], v[32]);
    PEER_CE(0, 8); PEER_CE(1, 9); PEER_CE(2, 10); PEER_CE(3, 11); PEER_CE(4, 12); PEER_CE(5, 13); PEER_CE(6, 14); PEER_CE(7, 15); PEER_CE(0, 4); PEER_CE(1, 5); PEER_CE(2, 6); PEER_CE(3, 7); PEER_CE(0, 2); PEER_CE(1, 3); PEER_CE(0, 1); PEER_CE(2, 3); PEER_CE(4, 6); PEER_CE(5, 7); PEER_CE(4, 5); PEER_CE(6, 7); PEER_CE(8, 12); PEER_CE(9, 13); PEER_CE(10, 14); PEER_CE(11, 15); PEER_CE(8, 10); PEER_CE(9, 11); PEER_CE(8, 9); PEER_CE(10, 11); PEER_CE(12, 14); PEER_CE(13, 15); PEER_CE(12, 13); PEER_CE(14, 15);
    unsigned pv[16];
#pragma unroll
    for (int i = 0; i < 16; ++i) { auto rr = __builtin_amdgcn_permlane32_swap(v[15 - i], v[15 - i], false, false); pv[i] = hi ? rr[0] : rr[1]; }
#pragma unroll
    for (int i = 0; i < 16; ++i) v[i] = umax(v[i], pv[i]);
    PEER_CE(0, 8); PEER_CE(1, 9); PEER_CE(2, 10); PEER_CE(3, 11); PEER_CE(4, 12); PEER_CE(5, 13); PEER_CE(6, 14); PEER_CE(7, 15); PEER_CE(0, 4); PEER_CE(1, 5); PEER_CE(2, 6); PEER_CE(3, 7); PEER_CE(0, 2); PEER_CE(1, 3); PEER_CE(0, 1); PEER_CE(2, 3); PEER_CE(4, 6); PEER_CE(5, 7); PEER_CE(4, 5); PEER_CE(6, 7); PEER_CE(8, 12); PEER_CE(9, 13); PEER_CE(10, 14); PEER_CE(11, 15); PEER_CE(8, 10); PEER_CE(9, 11); PEER_CE(8, 9); PEER_CE(10, 11); PEER_CE(12, 14); PEER_CE(13, 15); PEER_CE(12, 13); PEER_CE(14, 15);
}
__device__ __forceinline__ void top16_pair32(unsigned (&v)[32], int hi) {
    PEER_CE(0, 1); PEER_CE(2, 3); PEER_CE(0, 2); PEER_CE(1, 3); PEER_CE(1, 2); PEER_CE(4, 5); PEER_CE(6, 7); PEER_CE(4, 6); PEER_CE(5, 7); PEER_CE(5, 6); PEER_CE(0, 4); PEER_CE(2, 6); PEER_CE(2, 4); PEER_CE(1, 5); PEER_CE(3, 7); PEER_CE(3, 5); PEER_CE(1, 2); PEER_CE(3, 4); PEER_CE(5, 6); PEER_CE(8, 9); PEER_CE(10, 11); PEER_CE(8, 10); PEER_CE(9, 11); PEER_CE(9, 10); PEER_CE(12, 13); PEER_CE(14, 15); PEER_CE(12, 14); PEER_CE(13, 15); PEER_CE(13, 14); PEER_CE(8, 12); PEER_CE(10, 14); PEER_CE(10, 12); PEER_CE(9, 13); PEER_CE(11, 15); PEER_CE(11, 13); PEER_CE(9, 10); PEER_CE(11, 12); PEER_CE(13, 14); PEER_CE(0, 8); PEER_CE(4, 12); PEER_CE(4, 8); PEER_CE(2, 10); PEER_CE(6, 14); PEER_CE(6, 10); PEER_CE(2, 4); PEER_CE(6, 8); PEER_CE(10, 12); PEER_CE(1, 9); PEER_CE(5, 13); PEER_CE(5, 9); PEER_CE(3, 11); PEER_CE(7, 15); PEER_CE(7, 11); PEER_CE(3, 5); PEER_CE(7, 9); PEER_CE(11, 13); PEER_CE(1, 2); PEER_CE(3, 4); PEER_CE(5, 6); PEER_CE(7, 8); PEER_CE(9, 10); PEER_CE(11, 12); PEER_CE(13, 14);
    PEER_CE(16, 17); PEER_CE(18, 19); PEER_CE(16, 18); PEER_CE(17, 19); PEER_CE(17, 18); PEER_CE(20, 21); PEER_CE(22, 23); PEER_CE(20, 22); PEER_CE(21, 23); PEER_CE(21, 22); PEER_CE(16, 20); PEER_CE(18, 22); PEER_CE(18, 20); PEER_CE(17, 21); PEER_CE(19, 23); PEER_CE(19, 21); PEER_CE(17, 18); PEER_CE(19, 20); PEER_CE(21, 22); PEER_CE(24, 25); PEER_CE(26, 27); PEER_CE(24, 26); PEER_CE(25, 27); PEER_CE(25, 26); PEER_CE(28, 29); PEER_CE(30, 31); PEER_CE(28, 30); PEER_CE(29, 31); PEER_CE(29, 30); PEER_CE(24, 28); PEER_CE(26, 30); PEER_CE(26, 28); PEER_CE(25, 29); PEER_CE(27, 31); PEER_CE(27, 29); PEER_CE(25, 26); PEER_CE(27, 28); PEER_CE(29, 30); PEER_CE(16, 24); PEER_CE(20, 28); PEER_CE(20, 24); PEER_CE(18, 26); PEER_CE(22, 30); PEER_CE(22, 26); PEER_CE(18, 20); PEER_CE(22, 24); PEER_CE(26, 28); PEER_CE(17, 25); PEER_CE(21, 29); PEER_CE(21, 25); PEER_CE(19, 27); PEER_CE(23, 31); PEER_CE(23, 27); PEER_CE(19, 21); PEER_CE(23, 25); PEER_CE(27, 29); PEER_CE(17, 18); PEER_CE(19, 20); PEER_CE(21, 22); PEER_CE(23, 24); PEER_CE(25, 26); PEER_CE(27, 28); PEER_CE(29, 30);
    v[0] = umax(v[0], v[31]); v[1] = umax(v[1], v[30]); v[2] = umax(v[2], v[29]); v[3] = umax(v[3], v[28]); v[4] = umax(v[4], v[27]); v[5] = umax(v[5], v[26]); v[6] = umax(v[6], v[25]); v[7] = umax(v[7], v[24]); v[8] = umax(v[8], v[23]); v[9] = umax(v[9], v[22]); v[10] = umax(v[10], v[21]); v[11] = umax(v[11], v[20]); v[12] = umax(v[12], v[19]); v[13] = umax(v[13], v[18]); v[14] = umax(v[14], v[17]); v[15] = umax(v[15], v[16]);
    PEER_CE(0, 8); PEER_CE(1, 9); PEER_CE(2, 10); PEER_CE(3, 11); PEER_CE(4, 12); PEER_CE(5, 13); PEER_CE(6, 14); PEER_CE(7, 15); PEER_CE(0, 4); PEER_CE(1, 5); PEER_CE(2, 6); PEER_CE(3, 7); PEER_CE(0, 2); PEER_CE(1, 3); PEER_CE(0, 1); PEER_CE(2, 3); PEER_CE(4, 6); PEER_CE(5, 7); PEER_CE(4, 5); PEER_CE(6, 7); PEER_CE(8, 12); PEER_CE(9, 13); PEER_CE(10, 14); PEER_CE(11, 15); PEER_CE(8, 10); PEER_CE(9, 11); PEER_CE(8, 9); PEER_CE(10, 11); PEER_CE(12, 14); PEER_CE(13, 15); PEER_CE(12, 13); PEER_CE(14, 15);
    unsigned pv[16];
#pragma unroll
    for (int i = 0; i < 16; ++i) { auto rr = __builtin_amdgcn_permlane32_swap(v[15 - i], v[15 - i], false, false); pv[i] = hi ? rr[0] : rr[1]; }
#pragma unroll
    for (int i = 0; i < 16; ++i) v[i] = umax(v[i], pv[i]);
    PEER_CE(0, 8); PEER_CE(1, 9); PEER_CE(2, 10); PEER_CE(3, 11); PEER_CE(4, 12); PEER_CE(5, 13); PEER_CE(6, 14); PEER_CE(7, 15); PEER_CE(0, 4); PEER_CE(1, 5); PEER_CE(2, 6); PEER_CE(3, 7); PEER_CE(0, 2); PEER_CE(1, 3); PEER_CE(0, 1); PEER_CE(2, 3); PEER_CE(4, 6); PEER_CE(5, 7); PEER_CE(4, 5); PEER_CE(6, 7); PEER_CE(8, 12); PEER_CE(9, 13); PEER_CE(10, 14); PEER_CE(11, 15); PEER_CE(8, 10); PEER_CE(9, 11); PEER_CE(8, 9); PEER_CE(10, 11); PEER_CE(12, 14); PEER_CE(13, 15); PEER_CE(12, 13); PEER_CE(14, 15);
}
#undef PEER_CE
__device__ __forceinline__ void route(const bf16_t* query, const bf16_t* sk_l, int tok0, char* lds, int wave, int lane) {
    const int r32 = lane & 31, hi = lane >> 5, h = wave;
    unsigned* lists = (unsigned*)(lds + L_LIST) + (size_t)r32 * 256;
#pragma unroll 1
    for (int hc = 0; hc < 2; ++hc) {
        const bf16_t* sp = query + (size_t)(tok0 + r32) * DM + h * 256 + hc * 128 + hi * 64;
        unsigned v[64];
#pragma unroll
        for (int q8 = 0; q8 < 8; ++q8) { const v4u w = *(const v4u*)(sp + 8 * q8);
#pragma unroll
            for (int e2 = 0; e2 < 8; ++e2) { const int i = 8 * q8 + e2, kb = i >> 4, g4 = (i >> 2) & 3, e = i & 3; const unsigned kk = (unsigned)(kb * 32 + 8 * g4 + e) + 4u * (unsigned)hi;
                const unsigned wd = e2 < 2 ? w.x : e2 < 4 ? w.y : e2 < 6 ? w.z : w.w; v[i] = (ord_f((e2 & 1) ? bfhi(wd) : bflo(wd)) & ~127u) | kk; } }
        unsigned* lp = lists + (h * 2 + hc) * 16;
        top16_pair(v, hi);
        if (hi == 0) {
#pragma unroll
            for (int it = 0; it < TOPK; ++it) lp[it] = v[it]; }
    }
    const unsigned* la = lists + (h * 2) * 16; const unsigned* lb = la + 16;
    float av[16], bv[16];
#pragma unroll
    for (int i = 0; i < 16; ++i) { av[i] = unord_f(la[i] & ~127u); bv[i] = unord_f(lb[i] & ~127u); }
    unsigned cand[32];
#pragma unroll
    for (int n2 = 0; n2 < 25; ++n2) {
        const unsigned c0 = (ord_f(av[STAIR.i[2 * n2]] + bv[STAIR.j[2 * n2]]) & ~255u) | (unsigned)(STAIR.i[2 * n2] * 16 + STAIR.j[2 * n2]);
        const unsigned c1 = (ord_f(av[STAIR.i[2 * n2 + 1]] + bv[STAIR.j[2 * n2 + 1]]) & ~255u) | (unsigned)(STAIR.i[2 * n2 + 1] * 16 + STAIR.j[2 * n2 + 1]);
        cand[n2] = hi ? c1 : c0;
    }
#pragma unroll
    for (int n2 = 25; n2 < 32; ++n2) cand[n2] = 0u;
    top16_pair32(cand, hi);
    v2u* tab = (v2u*)(lds + L_TAB) + ((size_t)r32 * PEER_HEADS + h) * 16;
    if (hi == 0) {
#pragma unroll
        for (int it = 0; it < TOPK; ++it) { const unsigned m = cand[it]; const unsigned ia = la[(m >> 4) & 15u] & 127u, ib = lb[m & 15u] & 127u; v2u e; e.x = ia * NKEYS + ib; e.y = __float_as_uint(unord_f(m & ~255u)); tab[it] = e; }
    }
    if (hi == 0) {
        float sv[16]; float tot = 0.f;
#pragma unroll
        for (int i = 0; i < 16; ++i) sv[i] = __uint_as_float(tab[i].y);
        const float mx = sv[0];
#pragma unroll
        for (int i = 0; i < 16; ++i) { sv[i] = __expf(sv[i] - mx); tot += sv[i]; }
        const float inv = 1.0f / tot;
#pragma unroll
        for (int i = 0; i < 16; ++i) ((float*)(tab + i))[1] = sv[i] * inv;
    }
}

__device__ __forceinline__ void sort512(char* lds, int wave, int lane) {
    v2u* tabw = (v2u*)(lds + L_TAB) + (size_t)(4 * wave) * 128;
    unsigned k[8];
#pragma unroll
    for (int r = 0; r < 8; ++r) { const unsigned e = 8u * (unsigned)lane + r; k[r] = (tabw[e].x << 9) | e; }
#pragma unroll
    for (int kk = 1; kk <= 9; ++kk)
#pragma unroll
        for (int j = kk - 1; j >= 0; --j) {
            const int d = 1 << j, blk = 1 << kk;
            if (d >= 8) {
                const int dl = d >> 3; const bool lower = (lane & dl) == 0, up = kk == 9 ? true : (lane & (blk >> 3)) == 0, keepmin = lower == up;
#pragma unroll
                for (int r = 0; r < 8; ++r) { const unsigned y = (unsigned)__shfl_xor((int)k[r], dl); k[r] = keepmin ? umin(k[r], y) : umax(k[r], y); }
            } else {
#pragma unroll
                for (int r = 0; r < 8; ++r) { if (r & d) continue; const int r2 = r | d;
                    const bool up = blk >= 8 ? (kk == 9 ? true : (lane & (blk >> 3)) == 0) : (r & blk) == 0;
                    const unsigned lo = umin(k[r], k[r2]), hi = umax(k[r], k[r2]); k[r] = up ? lo : hi; k[r2] = up ? hi : lo; }
            }
        }
    unsigned g[8];
#pragma unroll
    for (int r = 0; r < 8; ++r) g[r] = tabw[k[r] & 511u].y;
    LDS_WAIT();
#pragma unroll
    for (int r = 0; r < 8; ++r) { const unsigned id = k[r] >> 9, ei = k[r] & 511u; v2u w; w.x = id | ((ei >> 7) << 14) | ((ei & 127u) << 16); w.y = g[r]; tabw[8 * lane + r] = w; }
}
__device__ __forceinline__ void sort_entries(char* lds, int wave, int lane) {
#pragma unroll 1
    for (int q = 0; q < 4; ++q) {
        const v2u* tab = (const v2u*)(lds + L_TAB) + (size_t)(4 * wave + q) * 128; v2u* st = (v2u*)(lds + L_STAB) + (size_t)(4 * wave + q) * 128;
        const v2u e0 = tab[lane], e1 = tab[lane + 64];
        const unsigned k0 = (e0.x << 7) | (unsigned)lane, k1 = (e1.x << 7) | (unsigned)(lane + 64);
        int r0 = 0, r1 = 0;
#pragma unroll 8
        for (int j = 0; j < 128; ++j) { const unsigned kj = (tab[j].x << 7) | (unsigned)j; r0 += kj < k0 ? 1 : 0; r1 += kj < k1 ? 1 : 0; }
        st[r0] = e0; st[r1] = e1;
    }
}
__device__ __forceinline__ void merge2_entries(char* lds, int wave, int lane) {
    const v2u* st = (const v2u*)(lds + L_STAB) + (size_t)(4 * wave) * 128; v2u* ml2 = (v2u*)(lds + L_ML2) + (size_t)(4 * wave) * 128;
#pragma unroll 2
    for (int tt = 0; tt < 4; ++tt)
#pragma unroll
        for (int half = 0; half < 2; ++half) {
            const int p = lane + 64 * half, o = tt ^ 1; const v2u e = st[tt * 128 + p];
            const unsigned lim = o < tt ? e.x + 1u : e.x;
            int lo = 0, hi = 128;
#pragma unroll
            for (int it = 0; it < 8; ++it) { const int mid = (lo + hi) >> 1; const bool open = lo < hi, lt = open && st[o * 128 + (mid < 127 ? mid : 127)].x < lim; lo = lt ? mid + 1 : lo; hi = (open && !lt) ? mid : hi; }
            v2u w; w.x = e.x | ((unsigned)(tt & 1) << 14) | ((unsigned)p << 16); w.y = e.y; ml2[(tt >> 1) * 256 + p + lo] = w;
        }
}
__device__ __forceinline__ void merge_entries(char* lds, int wave, int lane) {
    const v2u* st = (const v2u*)(lds + L_STAB) + (size_t)(4 * wave) * 128; v2u* ml = (v2u*)(lds + L_TAB) + (size_t)(4 * wave) * 128;
#pragma unroll 1
    for (int tt = 0; tt < 4; ++tt)
#pragma unroll
        for (int half = 0; half < 2; ++half) {
            const int p = lane + 64 * half; const v2u e = st[tt * 128 + p]; int rank = p;
#pragma unroll
            for (int oo = 1; oo < 4; ++oo) { const int o = (tt + oo) & 3;
                const unsigned lim = o < tt ? e.x + 1u : e.x;
                int lo = 0, hi = 128;
#pragma unroll
                for (int it = 0; it < 8; ++it) { const int mid = (lo + hi) >> 1; const bool open = lo < hi, lt = open && st[o * 128 + (mid < 127 ? mid : 127)].x < lim; lo = lt ? mid + 1 : lo; hi = (open && !lt) ? mid : hi; }
                rank += lo; }
            v2u w; w.x = e.x | ((unsigned)tt << 14) | ((unsigned)p << 16); w.y = e.y; ml[rank] = w;
        }
}
#define P8_ISSUE1(buf, rs_, idv, e) do { const unsigned so_ = ((unsigned)__builtin_amdgcn_readlane((int)(idv), lane_of(e)) & 16383u) * (unsigned)F6_ROW;     \
        const v4u a_ = __builtin_amdgcn_raw_buffer_load_b128(rs_, voff, so_, 0); const v2u b_ = __builtin_amdgcn_raw_buffer_load_b64(rs_, voffb, so_, 0); buf = (v6u){a_.x, a_.y, a_.z, a_.w, b_.x, b_.y}; } while (0)
#define P8_PIN1(buf, dep_) asm volatile("" : "+v"(buf) : "v"(dep_) : "memory")
#define P8_CVB(w_, sel_) __builtin_bit_cast(unsigned, __builtin_amdgcn_cvt_scalef32_pk_bf16_fp8((unsigned)(w_), 1.0f, sel_))
#define P8_DOT4(w_, xlo_, xhi_) do { d_ = dot2(P8_CVB(w_, false), (xlo_), d_); d_ = dot2(P8_CVB(w_, true), (xhi_), d_); } while (0)
#define P8_DOTX(buf, xr) do { _Pragma("unroll") for (int j_ = 0; j_ < 2; ++j_) { P8_DOT4(buf[j_].x, xr[2 * j_].x, xr[2 * j_].y); P8_DOT4(buf[j_].y, xr[2 * j_].z, xr[2 * j_].w); \
                                                            P8_DOT4(buf[j_].z, xr[2 * j_ + 1].x, xr[2 * j_ + 1].y); P8_DOT4(buf[j_].w, xr[2 * j_ + 1].z, xr[2 * j_ + 1].w); } } while (0)
#define P8_DOT1T(buf, e, dep_) do { P8_PIN1(buf, dep_); float d_ = 0.f; const int tt_ = (__builtin_amdgcn_readlane((int)ent.x, lane_of(e)) >> 14) & 3;     \
        if (tt_ == 0) P8_DOTX(buf, xr0); else if (tt_ == 1) P8_DOTX(buf, xr1); else if (tt_ == 2) P8_DOTX(buf, xr2); else P8_DOTX(buf, xr3); \
        pd[e] = d_; } while (0)
#define P8_CVT(w_, lo_, hi_) const auto lo_ = __builtin_amdgcn_cvt_pk_f32_fp8((int)(w_), false); const auto hi_ = __builtin_amdgcn_cvt_pk_f32_fp8((int)(w_), true)
typedef float f32x2_t __attribute__((ext_vector_type(2)));
#define P8_PKFMA(accp_, w2_, x2_) asm("v_pk_fma_f32 %0, %1, %2, %0" : "+v"(accp_) : "s"(w2_), "v"(x2_))
#define P8_FMA4(acc, w_, k_) do { const f32x2_t l2_ = __builtin_amdgcn_cvt_pk_f32_fp8((int)(w_), false), h2_ = __builtin_amdgcn_cvt_pk_f32_fp8((int)(w_), true); \
        P8_PKFMA(acc[(k_) >> 1], ws2_, l2_); P8_PKFMA(acc[((k_) >> 1) + 1], ws2_, h2_); } while (0)
#define P8_PINQ(a_, b_, dep_) asm volatile("" : "+v"(a_), "+v"(b_) : "v"(dep_))
typedef float v32f_t __attribute__((ext_vector_type(32)));
#define P8_FMAX(buf, acc) do { const v32f_t f_ = __builtin_amdgcn_cvt_scalef32_pk32_f32_fp6(buf, 1.0f);     \
        _Pragma("unroll") for (int j_ = 0; j_ < 16; ++j_) { const f32x2_t x2_ = {f_[2 * j_], f_[2 * j_ + 1]}; P8_PKFMA(acc[j_], ws2_, x2_); } vdep = acc[15].y; } while (0)
#define P8_FMA1T(buf, e) do { P8_PIN1(buf, vdep); const unsigned wsb_ = (unsigned)__builtin_amdgcn_readlane((int)__float_as_uint(wl), lane_of(e)); \
        const unsigned long long ws2_ = ((unsigned long long)wsb_ << 32) | wsb_;     \
        const int tt_ = (__builtin_amdgcn_readlane((int)ent.x, lane_of(e)) >> 14) & 1;     \
        if (tt_ == 0) P8_FMAX(buf, acc0); else P8_FMAX(buf, acc1); } while (0)
template <bool OUT16>
__device__ __forceinline__ void mix8(const bf16_t* xn, const float* partss, const unsigned char* eu_l, const unsigned char* ev_l, const float* us_l, const float* vs_l, const float* x1, float* xout,
                                     int tok0, const char* lds, int wave, int lane) {
    const int myslot = slot_of(lane); const unsigned voff = (unsigned)lane * 16u;
    const __amdgpu_buffer_rsrc_t ru = __builtin_amdgcn_make_buffer_rsrc((void*)eu_l, 0, NEXP * F6_ROW, 0x00020000), rv = __builtin_amdgcn_make_buffer_rsrc((void*)ev_l, 0, NEXP * F6_ROW, 0x00020000);
    const v2u* ml = (const v2u*)(lds + L_TAB) + (size_t)(4 * wave) * 128;
    const v2u* stw = (const v2u*)(lds + L_STAB) + (size_t)(4 * wave) * 128;
    float* wls = (float*)(lds + L_LIST) + wave * 512;
    const int t0 = tok0 + 4 * wave;
    v6u r0, r1, r2, r3, r4, r5, r6, r7; const unsigned voffb = 1024u + (unsigned)lane * 8u;
    {
        typedef int v8i_t __attribute__((ext_vector_type(8))); typedef int v4i_t __attribute__((ext_vector_type(4)));
        typedef int v6i_t __attribute__((ext_vector_type(6))); typedef int v2i_t __attribute__((ext_vector_type(2)));
        v6i_t tokA0, tokA1, tokA2, tokA3;
        float st0, st1, st2, st3;
#define P8_TOK(dst, sc_, tt_) do { float f_[32]; float am_ = 0.f; _Pragma("unroll") for (int i = 0; i < 4; ++i) { const v4u w = *(const v4u*)(xn + (size_t)(t0 + (tt_)) * DM + (size_t)(i >> 1) * 1024 + 16 * lane + 8 * (i & 1)); \
              f_[8 * i] = bflo(w.x); f_[8 * i + 1] = bfhi(w.x); f_[8 * i + 2] = bflo(w.y); f_[8 * i + 3] = bfhi(w.y); f_[8 * i + 4] = bflo(w.z); f_[8 * i + 5] = bfhi(w.z); f_[8 * i + 6] = bflo(w.w); f_[8 * i + 7] = bfhi(w.w); } \
          _Pragma("unroll") for (int i = 0; i < 32; ++i) am_ = fmaxf(am_, fabsf(f_[i])); \
          _Pragma("unroll") for (int o = 1; o < 64; o <<= 1) am_ = fmaxf(am_, __shfl_xor(am_, o)); \
          const float inv_ = am_ > 0.f ? 7.5f / am_ : 0.f; v32h_t h_; _Pragma("unroll") for (int i = 0; i < 32; ++i) h_[i] = (_Float16)(f_[i] * inv_); \
          dst = __builtin_bit_cast(v6i_t, __builtin_amdgcn_cvt_scalef32_pk32_fp6_f16(h_, 1.0f)); sc_ = am_ * (1.0f / 7.5f); } while (0)
        P8_TOK(tokA0, st0, 0); P8_TOK(tokA1, st1, 1); P8_TOK(tokA2, st2, 2); P8_TOK(tokA3, st3, 3);
#undef P8_TOK
        const float rs0 = row_rstd(partss, t0) * st0, rs1 = row_rstd(partss, t0 + 1) * st1, rs2 = row_rstd(partss, t0 + 2) * st2, rs3 = row_rstd(partss, t0 + 3) * st3;
        const int one8 = 0x7F7F7F7F, rsel = lane & 3; const bool isdiag = ((lane & 15) >> 2) == (lane >> 4);
        v6i_t u0, u1, u2, u3, u4, u5, u6, u7;
#define P8_LDRU(dst, idv, e) do { const unsigned so_ = ((unsigned)__builtin_amdgcn_readlane((int)(idv), lane_of(e)) & 16383u) * (unsigned)F6_ROW; \
            const v4i_t a_ = __builtin_bit_cast(v4i_t, __builtin_amdgcn_raw_buffer_load_b128(ru, voff, so_, 0)); const v2i_t b_ = __builtin_bit_cast(v2i_t, __builtin_amdgcn_raw_buffer_load_b64(ru, voffb, so_, 0)); \
            dst = (v6i_t){a_[0], a_[1], a_[2], a_[3], b_[0], b_[1]}; } while (0)
#define P8_MMA1(tok_, b_, k_) asm volatile("s_nop 1\n\tv_mfma_scale_f32_16x16x128_f8f6f4 %0, %1, %2, %0, %3, %3 op_sel_hi:[0,0,0] cbsz:2 blgp:2" : "+v"(d##k_) : "v"(tok_), "v"(b_), "v"(one8))
#define P8_MMT(b_, k_) do { const int tt_ = (__builtin_amdgcn_readlane((int)ent.x, lane_of(k_)) >> 14) & 3;     \
            if (tt_ < 2) { if (tt_ == 0) P8_MMA1(tokA0, b_, k_); else P8_MMA1(tokA1, b_, k_); } else { if (tt_ == 2) P8_MMA1(tokA2, b_, k_); else P8_MMA1(tokA3, b_, k_); } } while (0)
        { const unsigned idn = ml[myslot].x;
          P8_LDRU(u0, idn, 0); P8_LDRU(u1, idn, 1); P8_LDRU(u2, idn, 2); P8_LDRU(u3, idn, 3); P8_LDRU(u4, idn, 4); P8_LDRU(u5, idn, 5); P8_LDRU(u6, idn, 6); P8_LDRU(u7, idn, 7); }
#pragma unroll 1
        for (int g = 0; g < 32; ++g) {
            const v2u ent = ml[g * 16 + myslot];
            const unsigned eid = ent.x & 16383u, ett = (ent.x >> 14) & 3u, epos = ent.x >> 16;
            const v2u sc_ = *(const v2u*)(us_l + 2 * (size_t)eid); const float su = __uint_as_float(sc_.x), sv = __uint_as_float(sc_.y);
            const unsigned entn = ml[(g == 31 ? g : g + 1) * 16 + myslot].x;
            f32x4 d0 = {0.f, 0.f, 0.f, 0.f}, d1 = {0.f, 0.f, 0.f, 0.f}, d2 = {0.f, 0.f, 0.f, 0.f}, d3 = {0.f, 0.f, 0.f, 0.f}, d4 = {0.f, 0.f, 0.f, 0.f}, d5 = {0.f, 0.f, 0.f, 0.f}, d6 = {0.f, 0.f, 0.f, 0.f}, d7 = {0.f, 0.f, 0.f, 0.f}, d8 = {0.f, 0.f, 0.f, 0.f}, d9 = {0.f, 0.f, 0.f, 0.f}, d10 = {0.f, 0.f, 0.f, 0.f}, d11 = {0.f, 0.f, 0.f, 0.f}, d12 = {0.f, 0.f, 0.f, 0.f}, d13 = {0.f, 0.f, 0.f, 0.f}, d14 = {0.f, 0.f, 0.f, 0.f}, d15 = {0.f, 0.f, 0.f, 0.f};
            P8_MMT(u0, 0); P8_LDRU(u0, ent.x, 8);
            P8_MMT(u1, 1); P8_LDRU(u1, ent.x, 9);
            P8_MMT(u2, 2); P8_LDRU(u2, ent.x, 10);
            P8_MMT(u3, 3); P8_LDRU(u3, ent.x, 11);
            P8_MMT(u4, 4); P8_LDRU(u4, ent.x, 12);
            P8_MMT(u5, 5); P8_LDRU(u5, ent.x, 13);
            P8_MMT(u6, 6); P8_LDRU(u6, ent.x, 14);
            P8_MMT(u7, 7); P8_LDRU(u7, ent.x, 15);
            P8_MMT(u0, 8); P8_LDRU(u0, entn, 0);
            P8_MMT(u1, 9); P8_LDRU(u1, entn, 1);
            P8_MMT(u2, 10); P8_LDRU(u2, entn, 2);
            P8_MMT(u3, 11); P8_LDRU(u3, entn, 3);
            P8_MMT(u4, 12); P8_LDRU(u4, entn, 4);
            P8_MMT(u5, 13); P8_LDRU(u5, entn, 5);
            P8_MMT(u6, 14); P8_LDRU(u6, entn, 6);
            P8_MMT(u7, 15); P8_LDRU(u7, entn, 7);
            asm volatile("s_nop 15\n\ts_nop 3" : "+v"(d0), "+v"(d1), "+v"(d2), "+v"(d3), "+v"(d4), "+v"(d5), "+v"(d6), "+v"(d7), "+v"(d8), "+v"(d9), "+v"(d10), "+v"(d11), "+v"(d12), "+v"(d13), "+v"(d14), "+v"(d15));
            float pd[16];
            pd[0] = isdiag ? (rsel == 0 ? d0[0] : rsel == 1 ? d0[1] : rsel == 2 ? d0[2] : d0[3]) : 0.f;
            pd[1] = isdiag ? (rsel == 0 ? d1[0] : rsel == 1 ? d1[1] : rsel == 2 ? d1[2] : d1[3]) : 0.f;
            pd[2] = isdiag ? (rsel == 0 ? d2[0] : rsel == 1 ? d2[1] : rsel == 2 ? d2[2] : d2[3]) : 0.f;
            pd[3] = isdiag ? (rsel == 0 ? d3[0] : rsel == 1 ? d3[1] : rsel == 2 ? d3[2] : d3[3]) : 0.f;
            pd[4] = isdiag ? (rsel == 0 ? d4[0] : rsel == 1 ? d4[1] : rsel == 2 ? d4[2] : d4[3]) : 0.f;
            pd[5] = isdiag ? (rsel == 0 ? d5[0] : rsel == 1 ? d5[1] : rsel == 2 ? d5[2] : d5[3]) : 0.f;
            pd[6] = isdiag ? (rsel == 0 ? d6[0] : rsel == 1 ? d6[1] : rsel == 2 ? d6[2] : d6[3]) : 0.f;
            pd[7] = isdiag ? (rsel == 0 ? d7[0] : rsel == 1 ? d7[1] : rsel == 2 ? d7[2] : d7[3]) : 0.f;
            pd[8] = isdiag ? (rsel == 0 ? d8[0] : rsel == 1 ? d8[1] : rsel == 2 ? d8[2] : d8[3]) : 0.f;
            pd[9] = isdiag ? (rsel == 0 ? d9[0] : rsel == 1 ? d9[1] : rsel == 2 ? d9[2] : d9[3]) : 0.f;
            pd[10] = isdiag ? (rsel == 0 ? d10[0] : rsel == 1 ? d10[1] : rsel == 2 ? d10[2] : d10[3]) : 0.f;
            pd[11] = isdiag ? (rsel == 0 ? d11[0] : rsel == 1 ? d11[1] : rsel == 2 ? d11[2] : d11[3]) : 0.f;
            pd[12] = isdiag ? (rsel == 0 ? d12[0] : rsel == 1 ? d12[1] : rsel == 2 ? d12[2] : d12[3]) : 0.f;
            pd[13] = isdiag ? (rsel == 0 ? d13[0] : rsel == 1 ? d13[1] : rsel == 2 ? d13[2] : d13[3]) : 0.f;
            pd[14] = isdiag ? (rsel == 0 ? d14[0] : rsel == 1 ? d14[1] : rsel == 2 ? d14[2] : d14[3]) : 0.f;
            pd[15] = isdiag ? (rsel == 0 ? d15[0] : rsel == 1 ? d15[1] : rsel == 2 ? d15[2] : d15[3]) : 0.f;
#pragma unroll
            for (int i = 0; i < 8; ++i) { const float keep = (lane & 32) ? pd[i + 8] : pd[i], send = (lane & 32) ? pd[i] : pd[i + 8]; pd[i] = keep + __shfl_xor(send, 32); }
#pragma unroll
            for (int i = 0; i < 4; ++i) { const float keep = (lane & 16) ? pd[i + 4] : pd[i], send = (lane & 16) ? pd[i] : pd[i + 4]; pd[i] = keep + __shfl_xor(send, 16); }
#pragma unroll
            for (int i = 0; i < 2; ++i) { const float keep = (lane & 8) ? pd[i + 2] : pd[i], send = (lane & 8) ? pd[i] : pd[i + 2]; pd[i] = keep + __shfl_xor(send, 8); }
            { const float keep = (lane & 4) ? pd[1] : pd[0], send = (lane & 4) ? pd[0] : pd[1]; pd[0] = keep + __shfl_xor(send, 4); }
            pd[0] += __shfl_xor(pd[0], 2); pd[0] += __shfl_xor(pd[0], 1);
            const float rs = ett == 0 ? rs0 : ett == 1 ? rs1 : ett == 2 ? rs2 : rs3;
            wls[ett * 128 + epos] = __uint_as_float(ent.y) * gelu_exact(pd[0] * (su * rs)) * sv;
        }
#undef P8_LDRU
#undef P8_MMA1
#undef P8_MMT
    }
    {
        typedef float v32f_t __attribute__((ext_vector_type(32)));
        v32f_t A0, A1, A2, A3;
#pragma unroll
        for (int i = 0; i < 32; ++i) { A0[i] = 0.f; A1[i] = 0.f; A2[i] = 0.f; A3[i] = 0.f; }
#define P8_ROWV(buf, e) do { const unsigned wsb_ = (unsigned)__builtin_amdgcn_readlane((int)__float_as_uint(wl), lane_of(e)); const unsigned long long ws2_ = ((unsigned long long)wsb_ << 32) | wsb_; \
        const unsigned off_ = (((unsigned)__builtin_amdgcn_readlane((int)ent.x, lane_of(e)) >> 14) & 3u) * 32u;     \
        v32f_t f_; asm volatile("v_cvt_scalef32_pk32_f32_fp6 v[0:31], %[p], 1.0\n\ts_set_gpr_idx_on %[off], 0xc\n\ts_nop 1\n\t" \
            "v_pk_fma_f32 v[32:33], %[w], v[0:1], v[32:33]\n\tv_pk_fma_f32 v[34:35], %[w], v[2:3], v[34:35]\n\tv_pk_fma_f32 v[36:37], %[w], v[4:5], v[36:37]\n\tv_pk_fma_f32 v[38:39], %[w], v[6:7], v[38:39]\n\t" \
            "v_pk_fma_f32 v[40:41], %[w], v[8:9], v[40:41]\n\tv_pk_fma_f32 v[42:43], %[w], v[10:11], v[42:43]\n\tv_pk_fma_f32 v[44:45], %[w], v[12:13], v[44:45]\n\tv_pk_fma_f32 v[46:47], %[w], v[14:15], v[46:47]\n\t" \
            "v_pk_fma_f32 v[48:49], %[w], v[16:17], v[48:49]\n\tv_pk_fma_f32 v[50:51], %[w], v[18:19], v[50:51]\n\tv_pk_fma_f32 v[52:53], %[w], v[20:21], v[52:53]\n\tv_pk_fma_f32 v[54:55], %[w], v[22:23], v[54:55]\n\t" \
            "v_pk_fma_f32 v[56:57], %[w], v[24:25], v[56:57]\n\tv_pk_fma_f32 v[58:59], %[w], v[26:27], v[58:59]\n\tv_pk_fma_f32 v[60:61], %[w], v[28:29], v[60:61]\n\tv_pk_fma_f32 v[62:63], %[w], v[30:31], v[62:63]\n\t" \
            "s_set_gpr_idx_off" \
            : "+{v[32:63]}"(A0), "+{v[64:95]}"(A1), "+{v[96:127]}"(A2), "+{v[128:159]}"(A3), "=&{v[0:31]}"(f_) : [p] "v"(buf), [w] "s"(ws2_), [off] "s"(off_) : "memory"); } while (0)
        { const unsigned idn = ml[myslot].x;
          P8_ISSUE1(r0, rv, idn, 0); P8_ISSUE1(r1, rv, idn, 1); P8_ISSUE1(r2, rv, idn, 2); P8_ISSUE1(r3, rv, idn, 3); P8_ISSUE1(r4, rv, idn, 4); P8_ISSUE1(r5, rv, idn, 5); P8_ISSUE1(r6, rv, idn, 6); P8_ISSUE1(r7, rv, idn, 7); }
#pragma unroll 1
        for (int g = 0; g < 32; ++g) {
            const v2u ent = ml[g * 16 + myslot];
            const float wl = wls[((ent.x >> 14) & 3u) * 128 + (ent.x >> 16)];
            const unsigned entn = ml[(g == 31 ? g : g + 1) * 16 + myslot].x;
            P8_ROWV(r0, 0); P8_ISSUE1(r0, rv, ent.x, 8);
            P8_ROWV(r1, 1); P8_ISSUE1(r1, rv, ent.x, 9);
            P8_ROWV(r2, 2); P8_ISSUE1(r2, rv, ent.x, 10);
            P8_ROWV(r3, 3); P8_ISSUE1(r3, rv, ent.x, 11);
            P8_ROWV(r4, 4); P8_ISSUE1(r4, rv, ent.x, 12);
            P8_ROWV(r5, 5); P8_ISSUE1(r5, rv, ent.x, 13);
            P8_ROWV(r6, 6); P8_ISSUE1(r6, rv, ent.x, 14);
            P8_ROWV(r7, 7); P8_ISSUE1(r7, rv, ent.x, 15);
            P8_ROWV(r0, 8); P8_ISSUE1(r0, rv, entn, 0);
            P8_ROWV(r1, 9); P8_ISSUE1(r1, rv, entn, 1);
            P8_ROWV(r2, 10); P8_ISSUE1(r2, rv, entn, 2);
            P8_ROWV(r3, 11); P8_ISSUE1(r3, rv, entn, 3);
            P8_ROWV(r4, 12); P8_ISSUE1(r4, rv, entn, 4);
            P8_ROWV(r5, 13); P8_ISSUE1(r5, rv, entn, 5);
            P8_ROWV(r6, 14); P8_ISSUE1(r6, rv, entn, 6);
            P8_ROWV(r7, 15); P8_ISSUE1(r7, rv, entn, 7);
        }
        int lo = 16 * lane; asm volatile("" : "+v"(lo) :: "memory");
#define P8_OUT(A, tt_) do { _Pragma("unroll") for (int hf = 0; hf < 2; ++hf) _Pragma("unroll") for (int i = 0; i < 4; i += 2) { const size_t o = (size_t)(t0 + (tt_)) * DM + hf * 1024 + lo + 4 * i; \
            const v4u a = *(const v4u*)(xn + o); f32x4 r, q; const int b_ = (hf * 8 + 2 * i) * 2; \
            r.x = bflo(a.x) + A[b_]; r.y = bfhi(a.x) + A[b_ + 1]; r.z = bflo(a.y) + A[b_ + 2]; r.w = bfhi(a.y) + A[b_ + 3]; \
            q.x = bflo(a.z) + A[b_ + 4]; q.y = bfhi(a.z) + A[b_ + 5]; q.z = bflo(a.w) + A[b_ + 6]; q.w = bfhi(a.w) + A[b_ + 7]; \
            if (OUT16) { v4u w_; w_.x = pk2(r.x, r.y); w_.y = pk2(r.z, r.w); w_.z = pk2(q.x, q.y); w_.w = pk2(q.z, q.w); *(v4u*)((bf16_t*)xout + o) = w_; } \
            else { *(f32x4*)(xout + o) = r; *(f32x4*)(xout + o + 4) = q; } } } while (0)
        P8_OUT(A0, 0); P8_OUT(A1, 1); P8_OUT(A2, 2); P8_OUT(A3, 3);
#undef P8_OUT
#undef P8_ROWV
    }
}
#undef P8_ISSUE1
#undef P8_PIN1
#undef P8_CVB
#undef P8_DOT4
#undef P8_DOTX
#undef P8_DOT1T
#undef P8_CVT
#undef P8_FMA4
#undef P8_PINQ
#undef P8_FMAX
#undef P8_PKFMA
#undef P8_FMA1T
}
template <bool NEXT_NORM>
__device__ __forceinline__ void phase_peer(const bf16_t* xn, const float* partss, const bf16_t* query, const bf16_t* sk_l, const unsigned char* eu_l, const unsigned char* ev_l, const float* us_l, const float* vs_l, const float* x1, float* xout,
                                           const float* ngain, const float* nwin, const float* nbf, float* nlogf, bf16_t* nxn, const Ctx& c) {
    if (NEXT_NORM) {
        const f32x4* src = (const f32x4*)nwin; LAS f32x4* dstl = (LAS f32x4*)(c.lds + peer::L_STAB);
#pragma unroll
        for (int i = 0; i < 8 * DM / 4 / NTHREADS; ++i) dstl[c.tid + NTHREADS * i] = src[c.tid + NTHREADS * i];
        __syncthreads();
    }
    for (int chunk = blockIdx.x; chunk < T / peer::CH; chunk += gridDim.x) {
        const int tok0 = chunk * peer::CH;
        int lane1 = c.lane; asm volatile("" : "+v"(lane1));
        peer::route(query, sk_l, tok0, c.ldsg, c.wave, lane1);
        __syncthreads();
        int lane2 = c.lane; asm volatile("" : "+v"(lane2));
        peer::sort512(c.ldsg, c.wave, lane2);
        peer::mix8<NEXT_NORM>(xn, partss, eu_l, ev_l, us_l, vs_l, x1, xout, tok0, c.ldsg, c.wave, lane2);
        if (NEXT_NORM) {
            int lane3 = c.lane; asm volatile("" : "+v"(lane3));
            rmsnorm_rows4<const LAS float*, true>(xout, ngain, nxn, (const LAS float*)(c.lds + peer::L_STAB), nbf, nlogf, lane3, tok0 + 4 * c.wave);
        }
        __syncthreads();
    }
}

typedef const __attribute__((address_space(4))) Args* KArgs;
__device__ __forceinline__ KArgs opq(KArgs p) { asm volatile("" : "+s"(p)); return p; }
#define FRESH() do { int w_ = c.wave; unsigned z_ = 0u; asm volatile("" : "+s"(w_), "+v"(z_)); \
        c.tid = (w_ << 6) | (int)__builtin_amdgcn_mbcnt_hi(~0u, __builtin_amdgcn_mbcnt_lo(~0u, z_)); asm volatile("" : "+v"(c.tid)); c.lane = c.tid & 63; ka = opq(ka); } while (0)
#define WSP(T_, off) ((T_*)(ka->ws + (off)))

template <int l>
__device__ __forceinline__ void layer_body(KArgs ka, const Ctx& c_in, const XcdBarrier& bar) {
    Ctx c = c_in;
    FRESH();
    if (l == 0) {
#ifndef SKIP_P1
    { phase_rmsnorm4(ka->in[I_X], ka->in[I_MIXN], WSP(bf16_t, WS_XN8), ka->in[I_WIN], ka->in[I_BF], WSP(float, WS_LOGF), c); }
#endif
    xcd_barrier(bar, c.tid); FRESH();
    }
#ifndef SKIP_P2
    { pg8::Gemm g{WSP(const bf16_t, WS_XN8), (const bf16_t*)(WSP(const unsigned char, WS_WIN) + (size_t)l * NPACK * DM), T, NPACK, DM / 2};
      StaticOrderConv S; S.init(T, NPACK, (int)gridDim.x, (int)blockIdx.x); S.pick();
      S.row0 = 0; S.rstride = (int)gridDim.x * NWAVES; S.rowend = 0;
      S.wit0 = l + 1 < DEPTH ? (int)blockIdx.x * NWAVES + c.wave : -1;
      S.w_in = ka->in[I_WIN] + (size_t)(l + 1) * DM * IN_COLS; S.w_ba = ka->in[I_WBA] + (size_t)(l + 1) * A_OUT * DM; S.w_bb = ka->in[I_WBB] + (size_t)(l + 1) * B_OUT * DM; S.w_out = ka->in[I_WOUT] + (size_t)(l + 1) * DM * DM;
      S.w_in8 = WSP(unsigned char, WS_WIN) + (size_t)(l + 1) * NPACK * DM; S.w_ba8 = WSP(unsigned char, WS_WBA) + (size_t)(l + 1) * DM * A_OUT; S.w_bb8 = WSP(unsigned char, WS_WBB) + (size_t)(l + 1) * DM * B_OUT; S.w_out8 = WSP(unsigned char, WS_WOUT) + (size_t)(l + 1) * DM * DM;
      S.eu = ka->in[I_EU]; S.ev = ka->in[I_EV]; S.eu6 = WSP(unsigned char, WS_EU); S.ev6 = WSP(unsigned char, WS_EV); S.scl = WSP(float, WS_EUS); S.gain = ka->in[I_FFNN];
      decay_cumsum(WSP(const float, WS_LOGF), WSP(float, WS_KBIAS), WSP(float, WS_ZBIAS), c);
      EpiProjFused E{WSP(bf16_t, WS_Q), WSP(bf16_t, WS_K), WSP(bf16_t, WS_V), WSP(bf16_t, WS_GATE), ka->in[I_QN] + (size_t)l * NHEADS * HD, ka->in[I_KN] + (size_t)l * NHEADS * HD, WSP(const float, WS_ROT), c.lds, ka->in[I_BG] + (size_t)l * 2 * DM};
      pg8::gemm_phase<EpiProjFused, StaticOrderConv, true, true, true>(c.lds, g, S, E, c.tid); }
#endif
    xcd_barrier(bar, c.tid); FRESH();
#ifndef SKIP_P4
#ifdef ATT_NAIVE
    phase_attn_naive(WSP(const bf16_t, WS_Q), WSP(const bf16_t, WS_K), WSP(const bf16_t, WS_V), WSP(const float, WS_KBIAS), WSP(bf16_t, WS_OA), WSP(bf16_t, WS_OB), c);
#else
    { AttPtrs P{WSP(const bf16_t, WS_Q), WSP(const bf16_t, WS_K), WSP(const bf16_t, WS_V), WSP(const float, WS_KBIAS), WSP(const float, WS_ZBIAS),
                 WSP(bf16_t, WS_PROJ), WSP(bf16_t, WS_PROJ + 8 * MiB), WSP(float, WS_PROJ + 16 * MiB), WSP(float, WS_PROJ + 17 * MiB), (bf16_t*)WSP(unsigned char, WS_MERGED + 16 * MiB)};
      att::Bg bg; bg.src = ka->in[I_EV]; bg.dst = WSP(unsigned char, WS_EV); bg.scl = WSP(float, WS_EUS) + 1; bg.rstride = (int)gridDim.x * NWAVES;
      bg.srcU = ka->in[I_EU]; bg.dstU = WSP(unsigned char, WS_EU); bg.gain = 0; bg.gA = c.lds + 126976; static_assert(EX_OFF + 8192 - 126976 == 13312, "gain piece B offset");
      bg.first = l * NEXP + (int)blockIdx.x * NWAVES + c.wave; bg.next = bg.first; bg.rowend = (l + 1) * NEXP; bg.pend = -1; bg.slot = c.lds + (c.wave < 7 ? 69632 + c.wave * 8192 : EX_OFF);
      { const f32x4 g_ = *(const f32x4*)(ka->in[I_FFNN] + (size_t)l * DM + 4 * c.tid);
        *(LAS f32x4*)(bg.gA + (c.tid < 256 ? 0 : 13312) + 16 * (c.tid & 255)) = g_; }
      phase_attn(P, c.ldsg, c.tid, bg);
      asm volatile("s_waitcnt vmcnt(0)" ::: "memory"); __syncthreads();
      FRESH();
      if (bg.pend >= 0) att::bg_consume(bg, c.lane);
      if (!bg.gain) { convert_fp6_rows_b4(ka->in[I_EV], WSP(unsigned char, WS_EV), WSP(float, WS_EUS) + 1, bg.next, bg.rstride, bg.rowend, c.lane);
                      convert_fp6_rows_b4(ka->in[I_EU], WSP(unsigned char, WS_EU), WSP(float, WS_EUS), bg.first, bg.rstride, bg.rowend, c.lane, ka->in[I_FFNN]); }
      else convert_fp6_rows_b4(ka->in[I_EU], WSP(unsigned char, WS_EU), WSP(float, WS_EUS), bg.next, bg.rstride, bg.rowend, c.lane, ka->in[I_FFNN]); }
#endif
#endif
    xcd_barrier(bar, c.tid); FRESH();
#ifndef SKIP_P4
    phase_attn_combine(WSP(const bf16_t, WS_PROJ), WSP(const bf16_t, WS_PROJ + 8 * MiB), WSP(const float, WS_PROJ + 16 * MiB), WSP(const float, WS_PROJ + 17 * MiB), WSP(unsigned char, WS_OA), WSP(const bf16_t, WS_OB), WSP(unsigned char, WS_MERGED + 16 * MiB), c);
#endif
    xcd_barrier(bar, c.tid); FRESH();
#ifndef SKIP_P5
    { pg8::StaticOrder S; S.init(T, DM, (int)gridDim.x, (int)blockIdx.x);
      { pg8::OneUnit S1; if (S.next(0, S1.u)) {
        pg8::f32x4 acc[2][2][4][2];
        { pg8::Gemm g{WSP(const bf16_t, WS_OA), (const bf16_t*)(WSP(const unsigned char, WS_WBA) + (size_t)l * DM * A_OUT), T, DM, A_OUT / 2};
          EpiBranchScale E{WSP(const bf16_t, WS_GATE)};
          pg8::gemm_phase_acc<EpiBranchScale, pg8::OneUnit, true, true, true, true, O_SHIFT>(c.lds, g, S1, E, c.tid, acc); }
        { pg8::Gemm g{WSP(const bf16_t, WS_MERGED + 16 * MiB), (const bf16_t*)(WSP(const unsigned char, WS_WBB) + (size_t)l * DM * B_OUT), T, DM, B_OUT / 2};
          EpiBranchOut E{WSP(bf16_t, WS_MERGED), (const bf16_t*)(WSP(const unsigned char, WS_GATE) + DM)};
          pg8::gemm_phase_acc<EpiBranchOut, pg8::OneUnit, true, true, true, false, O_SHIFT>(c.lds, g, S1, E, c.tid, acc); }
      } } }
#endif
    xcd_barrier(bar, c.tid); FRESH();
#ifndef SKIP_P6
    { const float* xin = l == 0 ? ka->in[I_X] : WSP(const float, WS_XCUR);
      pg8::Gemm g{WSP(const bf16_t, WS_MERGED), (const bf16_t*)(WSP(const unsigned char, WS_WOUT) + (size_t)l * DM * DM), T, DM, DM / 2}; pg8::StaticOrder S; S.init(T, DM, (int)gridDim.x, (int)blockIdx.x);
      EpiResidualNorm<(l > 0)> E{xin, WSP(bf16_t, WS_XN), WSP(float, WS_PARTSS), c.lds, WSP(unsigned char, WS_X1)};
      pg8::gemm_phase<EpiResidualNorm<(l > 0)>, pg8::StaticOrder, true, true, true, MRG_SHIFT>(c.lds, g, S, E, c.tid); }
#endif
    xcd_barrier(bar, c.tid); FRESH();
#ifndef SKIP_P8
    { pg8::Gemm g{WSP(const bf16_t, WS_X1), (const bf16_t*)(WSP(const unsigned char, WS_WQ) + (size_t)l * DM * DM), T, DM, DM / 2}; pg8::StaticOrder S; S.init(T, DM, (int)gridDim.x, (int)blockIdx.x);
      EpiBf16RowScale E{WSP(bf16_t, WS_QUERY), DM, WSP(const float, WS_PARTSS)};
      pg8::gemm_phase<EpiBf16RowScale, pg8::StaticOrder, true, true, true, X1_SHIFT>(c.lds, g, S, E, c.tid); }
#endif
    xcd_barrier(bar, c.tid); FRESH();
#ifndef SKIP_P9
    { float* xout = l == DEPTH - 1 ? ka->out : WSP(float, WS_XCUR);
      phase_peer<(l + 1 < DEPTH)>(WSP(const bf16_t, WS_XN), WSP(const float, WS_PARTSS), WSP(const bf16_t, WS_QUERY), WSP(const bf16_t, WS_SK) + (size_t)l * PEER_HEADS * 2 * NKEYS * HD,
                 WSP(const unsigned char, WS_EU) + (size_t)l * NEXP * F6_ROW, WSP(const unsigned char, WS_EV) + (size_t)l * NEXP * F6_ROW,
                 WSP(const float, WS_EUS) + (size_t)l * NEXP * 2, WSP(const float, WS_EUS) + (size_t)l * NEXP * 2, WSP(const float, WS_X1), xout,
                 ka->in[I_MIXN] + (size_t)(l + 1 < DEPTH ? l + 1 : l) * DM, WSP(const float, WS_WF) + (size_t)(l + 1 < DEPTH ? l + 1 : l) * 8 * DM, ka->in[I_BF] + (l + 1 < DEPTH ? l + 1 : l) * FOX_HEADS,
                 WSP(float, WS_LOGF), WSP(bf16_t, WS_XN8), c); }
#endif
    if (l + 1 < DEPTH) xcd_barrier(bar, c.tid);
}

__global__ void __launch_bounds__(NTHREADS, 2) fwd_kernel(Args a_unused) {
    extern __shared__ __attribute__((aligned(16))) unsigned char lds_raw[];
    (void)a_unused;
    KArgs ka = (KArgs)__builtin_amdgcn_kernarg_segment_ptr();
    Ctx c; c.lds = (LAS unsigned char*)lds_raw; c.ldsg = (char*)lds_raw; c.tid = threadIdx.x; c.lane = c.tid & 63; c.wave = __builtin_amdgcn_readfirstlane(c.tid >> 6);
    c.gw = blockIdx.x * NWAVES + c.wave; c.ngw = gridDim.x * NWAVES;
    volatile LAS unsigned* misc = (volatile LAS unsigned*)(c.lds + MISC_OFF);
    if (c.tid < 64) misc[c.tid] = 0u;
    __syncthreads();
    XcdBarrier bar = xcd_barrier_post((unsigned*)(ka->ws + WS_CTL) + CW_BAR, misc + 8, c.tid);
#ifndef SKIP_P0
    phase_convert(ka, c);
#endif
    layer_body<0>(ka, c, bar);
    layer_body<1>(ka, c, bar);
}
#undef FRESH
#undef WSP

extern "C" void kernel_launch(void* const* d_in, const int* in_sizes, int n_in, void* d_out, int out_size, void* d_ws, size_t ws_size, hipStream_t stream) {
    static int grid = 0;
    if (grid == 0) {
        if (n_in != 15 || out_size != T * DM || ws_size < WS_END) {
            fprintf(stderr, "kernel_launch: unexpected shapes (n_in %d, out %d, ws %zu, need %zu); nothing launched\n", n_in, out_size, ws_size, (size_t)WS_END); grid = -1; return; }
        int dev = 0, cus = 0;
        if (hipGetDevice(&dev) != hipSuccess || hipDeviceGetAttribute(&cus, hipDeviceAttributeMultiprocessorCount, dev) != hipSuccess || cus <= 0) cus = 256;
        if (hipFuncSetAttribute((const void*)fwd_kernel, hipFuncAttributeMaxDynamicSharedMemorySize, LDS_BYTES) != hipSuccess) { fprintf(stderr, "kernel_launch: hipFuncSetAttribute failed\n"); grid = -1; return; }
        int per_cu = 0;
        if (hipOccupancyMaxActiveBlocksPerMultiprocessor(&per_cu, (const void*)fwd_kernel, NTHREADS, LDS_BYTES) != hipSuccess || per_cu < 1)
            fprintf(stderr, "kernel_launch: occupancy query says %d workgroups per CU\n", per_cu);
        (void)hipGetLastError();
        grid = cus;
    }
    if (grid < 0) return;
    (void)in_sizes;
    if (hipMemsetAsync((char*)d_ws + WS_CTL, 0, CTL_ZERO_BYTES, stream) != hipSuccess) { fprintf(stderr, "kernel_launch: memset failed\n"); return; }
    Args a{};
    for (int i = 0; i < 15; ++i) a.in[i] = (const float*)d_in[i];
    a.out = (float*)d_out; a.ws = (unsigned char*)d_ws;
    hipLaunchKernelGGL(fwd_kernel, dim3(grid), dim3(NTHREADS), LDS_BYTES, stream, a);
}
```
